# Optimizing an MI355X kernel written in HIP

```python
import math
import jax, jax.numpy as jnp
from jax import lax
import numpy as np

D_MODEL = 1024
BATCH = 4
SEQ = 8192
DEPTH = 1
DEC_BATCH = 2
DEC_SEQ = 8192
PAST_LEN = 128

D_FF = 2816
SSM_HEADS = 16
SSM_HEAD_DIM = 64
D_SSM = SSM_HEADS * SSM_HEAD_DIM
SSM_GROUPS = 2
D_STATE = 128
CONV_K = 5
CONV_DIM = D_SSM + 2 * SSM_GROUPS * D_STATE
CHUNK = 128
N_HEADS = 16
KV_HEADS = 4
HEAD_DIM = 64
D_ATTN = N_HEADS * HEAD_DIM
D_KV = KV_HEADS * HEAD_DIM
WINDOW = 128
BLK = 128
D_MIX = D_SSM + D_ATTN
IN_SPLITS = (D_SSM, CONV_DIM, SSM_HEADS, SSM_HEADS, D_ATTN, D_KV, D_KV)
D_IN_PROJ = sum(IN_SPLITS)
EPS = 1e-6

kernel_name = "hymba_bidir_ssd_swa_macaron_encoder"


def rmsnorm(x, w):
    xf = x.astype(jnp.float32)
    y = xf * lax.rsqrt(jnp.mean(xf * xf, axis=-1, keepdims=True) + EPS)
    return (y * w.astype(jnp.float32)).astype(x.dtype)


def swiglu(x, w_gate, w_up, w_down):
    return (jax.nn.silu(x @ w_gate) * (x @ w_up)) @ w_down


def centred_depthwise_conv(u, w, b):
    S = u.shape[1]
    pad = (CONV_K - 1) // 2
    up = jnp.pad(u, ((0, 0), (pad, pad), (0, 0)))
    out = b
    for k in range(CONV_K):
        out = out + up[:, k:k + S] * w[k]
    return out


def ssd_scan(xh, dt, a, Bm, Cm):
    b, S, h, p = xh.shape
    nc = S // CHUNK
    g = SSM_GROUPS
    hg = h // g
    xdt = (xh * dt[..., None]).reshape(b, nc, CHUNK, g, hg, p)
    dA = (dt * a).reshape(b, nc, CHUNK, g, hg)
    Bc = Bm.reshape(b, nc, CHUNK, g, D_STATE)
    Cc = Cm.reshape(b, nc, CHUNK, g, D_STATE)
    cs = jnp.cumsum(dA, axis=2)
    seg = cs[:, :, :, None] - cs[:, :, None, :]
    tril = jnp.tril(jnp.ones((CHUNK, CHUNK), dtype=bool))[None, None, :, :, None, None]
    Lmat = jnp.exp(jnp.where(tril, seg, -jnp.inf))
    CB = jnp.einsum('bclgn,bcsgn->bclsg', Cc, Bc)
    y_diag = jnp.einsum('bclsgj,bcsgjp->bclgjp', CB[..., None] * Lmat, xdt)
    decay = jnp.exp(cs[:, :, -1:] - cs)
    states = jnp.einsum('bclgn,bclgjp->bcgjpn', Bc, decay[..., None] * xdt)
    chunk_decay = jnp.exp(cs[:, :, -1])

    def step(carry, inp):
        st, dec = inp
        return carry * dec[..., None, None] + st, carry

    init = jnp.zeros((b, g, hg, p, D_STATE), jnp.float32)
    _, prev = lax.scan(step, init, (jnp.swapaxes(states, 0, 1), jnp.swapaxes(chunk_decay, 0, 1)))
    prev = jnp.swapaxes(prev, 0, 1)
    y_off = jnp.einsum('bclgn,bcgjpn->bclgjp', Cc, prev) * jnp.exp(cs)[..., None]
    return (y_diag + y_off).reshape(b, S, h, p)


def ssd_mixer(z, xBC, dt_f_raw, dt_b_raw, conv_w, conv_b, dt_bias_fwd, dt_bias_bwd,
              a_log_fwd, a_log_bwd, d_skip, ssm_norm_w):
    b, S, _ = z.shape
    u = jax.nn.silu(centred_depthwise_conv(xBC, conv_w, conv_b)).astype(jnp.float32)
    xs, Bm, Cm = jnp.split(u, [D_SSM, D_SSM + SSM_GROUPS * D_STATE], axis=-1)
    xh = xs.reshape(b, S, SSM_HEADS, SSM_HEAD_DIM)
    Bm = Bm.reshape(b, S, SSM_GROUPS, D_STATE)
    Cm = Cm.reshape(b, S, SSM_GROUPS, D_STATE)
    dt_f = jax.nn.softplus(dt_f_raw.astype(jnp.float32) + dt_bias_fwd.astype(jnp.float32))
    dt_b = jax.nn.softplus(dt_b_raw.astype(jnp.float32) + dt_bias_bwd.astype(jnp.float32))
    a_f = -jnp.exp(a_log_fwd.astype(jnp.float32))
    a_b = -jnp.exp(a_log_bwd.astype(jnp.float32))
    y_f = ssd_scan(xh, dt_f, a_f, Bm, Cm)
    y_b = jnp.flip(ssd_scan(jnp.flip(xh, 1), jnp.flip(dt_b, 1), a_b,
                            jnp.flip(Bm, 1), jnp.flip(Cm, 1)), 1)
    y = y_f + y_b + xh * d_skip.astype(jnp.float32)[:, None]
    y = y.reshape(b, S, D_SSM) * jax.nn.silu(z.astype(jnp.float32))
    yg = y.reshape(b, S, SSM_GROUPS, D_SSM // SSM_GROUPS)
    yg = yg * lax.rsqrt(jnp.mean(yg * yg, axis=-1, keepdims=True) + EPS)
    y = yg.reshape(b, S, D_SSM) * ssm_norm_w.astype(jnp.float32)
    return y.astype(z.dtype)


def windowed_gqa(q, k, v, attn_sink):
    b, S, _ = q.shape
    G = N_HEADS // KV_HEADS
    nblk = S // BLK
    qh = q.reshape(b, S, KV_HEADS, G, HEAD_DIM)
    kp = jnp.pad(k.reshape(b, S, KV_HEADS, HEAD_DIM), ((0, 0), (BLK, BLK), (0, 0), (0, 0)))
    vp = jnp.pad(v.reshape(b, S, KV_HEADS, HEAD_DIM), ((0, 0), (BLK, BLK), (0, 0), (0, 0)))
    slopes = jnp.exp2(-(8.0 / N_HEADS) * jnp.arange(1, N_HEADS + 1, dtype=jnp.float32))
    slopes = slopes.reshape(KV_HEADS, G)[None, :, :, None, None]
    sink = attn_sink.astype(jnp.float32).reshape(KV_HEADS, G)[None, :, :, None, None]
    scale = 1.0 / math.sqrt(HEAD_DIM)

    def block(i):
        qs = i * BLK
        qb = lax.dynamic_slice_in_dim(qh, qs, BLK, axis=1)
        kb = lax.dynamic_slice_in_dim(kp, qs, 3 * BLK, axis=1)
        vb = lax.dynamic_slice_in_dim(vp, qs, 3 * BLK, axis=1)
        s = jnp.einsum('bqkgd,bskd->bkgqs', qb, kb,
                       preferred_element_type=jnp.float32) * scale
        tpos = qs + jnp.arange(BLK)
        spos = qs - BLK + jnp.arange(3 * BLK)
        dist = jnp.abs(tpos[:, None] - spos[None, :])
        valid = (dist <= WINDOW) & (spos >= 0)[None, :] & (spos < S)[None, :]
        s = s - slopes * dist.astype(jnp.float32)
        s = jnp.where(valid, s, -jnp.inf)
        mx = jnp.maximum(jnp.max(s, axis=-1, keepdims=True), sink)
        p = jnp.exp(s - mx)
        den = jnp.sum(p, axis=-1, keepdims=True) + jnp.exp(sink - mx)
        o = jnp.einsum('bkgqs,bskd->bqkgd', p / den, vb.astype(jnp.float32))
        return o

    out = lax.map(block, jnp.arange(nblk))
    out = jnp.swapaxes(out, 0, 1).reshape(b, S, D_ATTN)
    return out.astype(q.dtype)


def parallel_mixer(h, w_in, conv_w, conv_b, dt_bias_fwd, dt_bias_bwd, a_log_fwd, a_log_bwd,
                   d_skip, ssm_norm_w, attn_sink, w_out):
    proj = h @ w_in
    idx = list(np.cumsum(IN_SPLITS)[:-1])
    z, xBC, dt_f, dt_b, q, k, v = jnp.split(proj, idx, axis=-1)
    y_ssm = ssd_mixer(z, xBC, dt_f, dt_b, conv_w, conv_b, dt_bias_fwd, dt_bias_bwd,
                      a_log_fwd, a_log_bwd, d_skip, ssm_norm_w)
    y_att = windowed_gqa(q, k, v, attn_sink)
    return jnp.concatenate([y_ssm, y_att], axis=-1) @ w_out


def trunk(x, norm_ffn1_w, ffn1_w_gate, ffn1_w_up, ffn1_w_down, norm_mix_w, w_in, conv_w, conv_b,
          dt_bias_fwd, dt_bias_bwd, a_log_fwd, a_log_bwd, d_skip, ssm_norm_w, attn_sink, w_out,
          norm_ffn2_w, ffn2_w_gate, ffn2_w_up, ffn2_w_down, norm_final_w):
    for l in range(DEPTH):
        x = x + 0.5 * swiglu(rmsnorm(x, norm_ffn1_w[l]), ffn1_w_gate[l], ffn1_w_up[l], ffn1_w_down[l])
        x = x + parallel_mixer(rmsnorm(x, norm_mix_w[l]), w_in[l], conv_w[l], conv_b[l],
                               dt_bias_fwd[l], dt_bias_bwd[l], a_log_fwd[l], a_log_bwd[l],
                               d_skip[l], ssm_norm_w[l], attn_sink[l], w_out[l])
        x = x + 0.5 * swiglu(rmsnorm(x, norm_ffn2_w[l]), ffn2_w_gate[l], ffn2_w_up[l], ffn2_w_down[l])
    return rmsnorm(x, norm_final_w)


def setup_inputs(seed: int = 0) -> dict:
    key = jax.random.key(seed)
    ks = jax.random.split(key, 24)
    f32 = jnp.float32

    def nrm(k, shape, scale):
        return jax.random.normal(k, shape, f32) * scale

    def gain(k, shape):
        return 1.0 + 0.02 * jax.random.normal(k, shape, f32)

    dt_init_f = jnp.exp(jax.random.uniform(ks[10], (DEPTH, SSM_HEADS), f32, math.log(1e-3), math.log(1e-1)))
    dt_init_b = jnp.exp(jax.random.uniform(ks[11], (DEPTH, SSM_HEADS), f32, math.log(1e-3), math.log(1e-1)))
    return {
        "x_prompt": nrm(ks[0], (BATCH, SEQ, D_MODEL), 1.0),
        "x_sample": nrm(ks[1], (DEC_BATCH, DEC_SEQ, D_MODEL), 1.0),
        "norm_ffn1_w": gain(ks[2], (DEPTH, D_MODEL)),
        "ffn1_w_gate": nrm(ks[3], (DEPTH, D_MODEL, D_FF), D_MODEL ** -0.5),
        "ffn1_w_up": nrm(ks[4], (DEPTH, D_MODEL, D_FF), D_MODEL ** -0.5),
        "ffn1_w_down": nrm(ks[5], (DEPTH, D_FF, D_MODEL), D_FF ** -0.5),
        "norm_mix_w": gain(ks[6], (DEPTH, D_MODEL)),
        "w_in": nrm(ks[7], (DEPTH, D_MODEL, D_IN_PROJ), D_MODEL ** -0.5),
        "conv_w": nrm(ks[8], (DEPTH, CONV_K, CONV_DIM), CONV_K ** -0.5),
        "conv_b": nrm(ks[9], (DEPTH, CONV_DIM), 0.02),
        "dt_bias_fwd": dt_init_f + jnp.log(-jnp.expm1(-dt_init_f)),
        "dt_bias_bwd": dt_init_b + jnp.log(-jnp.expm1(-dt_init_b)),
        "a_log_fwd": jnp.log(jax.random.uniform(ks[12], (DEPTH, SSM_HEADS), f32, 1.0, 16.0)),
        "a_log_bwd": jnp.log(jax.random.uniform(ks[13], (DEPTH, SSM_HEADS), f32, 1.0, 16.0)),
        "d_skip": 1.0 + 0.1 * jax.random.normal(ks[14], (DEPTH, SSM_HEADS), f32),
        "ssm_norm_w": gain(ks[15], (DEPTH, D_SSM)),
        "attn_sink": nrm(ks[16], (DEPTH, N_HEADS), 0.5),
        "w_out": nrm(ks[17], (DEPTH, D_MIX, D_MODEL), D_MIX ** -0.5),
        "norm_ffn2_w": gain(ks[18], (DEPTH, D_MODEL)),
        "ffn2_w_gate": nrm(ks[19], (DEPTH, D_MODEL, D_FF), D_MODEL ** -0.5),
        "ffn2_w_up": nrm(ks[20], (DEPTH, D_MODEL, D_FF), D_MODEL ** -0.5),
        "ffn2_w_down": nrm(ks[21], (DEPTH, D_FF, D_MODEL), D_FF ** -0.5),
        "norm_final_w": gain(ks[22], (D_MODEL,)),
    }


def reference(x_prompt, x_sample, norm_ffn1_w, ffn1_w_gate, ffn1_w_up, ffn1_w_down, norm_mix_w,
              w_in, conv_w, conv_b, dt_bias_fwd, dt_bias_bwd, a_log_fwd, a_log_bwd, d_skip,
              ssm_norm_w, attn_sink, w_out, norm_ffn2_w, ffn2_w_gate, ffn2_w_up, ffn2_w_down,
              norm_final_w):
    y_prompt = trunk(x_prompt, norm_ffn1_w, ffn1_w_gate, ffn1_w_up, ffn1_w_down, norm_mix_w, w_in,
                     conv_w, conv_b, dt_bias_fwd, dt_bias_bwd, a_log_fwd, a_log_bwd, d_skip,
                     ssm_norm_w, attn_sink, w_out, norm_ffn2_w, ffn2_w_gate, ffn2_w_up,
                     ffn2_w_down, norm_final_w)
    y_sample = trunk(x_sample, norm_ffn1_w, ffn1_w_gate, ffn1_w_up, ffn1_w_down, norm_mix_w, w_in,
                     conv_w, conv_b, dt_bias_fwd, dt_bias_bwd, a_log_fwd, a_log_bwd, d_skip,
                     ssm_norm_w, attn_sink, w_out, norm_ffn2_w, ffn2_w_gate, ffn2_w_up,
                     ffn2_w_down, norm_final_w)
    return (y_prompt, y_sample)
```

```cpp
#include <hip/hip_runtime.h>
#include <hip/hip_cooperative_groups.h>
#include <cstdio>
#include <cstdint>
namespace cg = cooperative_groups;
namespace pg8 {
#define PG8_LAS __attribute__((address_space(3)))
typedef unsigned short bf16_t;
typedef short bf16x8 __attribute__((ext_vector_type(8)));
typedef float f32x4 __attribute__((ext_vector_type(4)));
typedef unsigned u32x4 __attribute__((ext_vector_type(4)));
constexpr int BM = 256, BK = 64, HALF = 128, HTB = HALF * BK * 2  , STAGE_BYTES = 8 * HTB, NXCD = 8, WGM = 8;

__host__ __device__ __forceinline__ int lds_byte(int r, int c) { const int st = (r >> 4) * 2 + (c >> 5), rr = r & 15, cc = c & 31, ob = rr * 64 + cc * 2; return st * 1024 + (ob ^ (((ob >> 9) & 1) << 5)); }
__host__ __device__ __forceinline__ void stage_rc(int b, int& R, int& C) { const int st = b / 1024, sb = b % 1024, swz = sb ^ (((sb >> 9) & 1) << 5); R = (st >> 1) * 16 + swz / 64; C = (st & 1) * 32 + (swz % 64) / 2; }
__host__ __device__ __forceinline__ int perm32(int rho) { const int n = rho >> 4, i = rho & 15; return 8 * (i >> 2) + 4 * n + (i & 3); }

struct Unit { int pm, pn; };
struct Gemm { const bf16_t* A; const bf16_t* Bt; int M, N, K; };

struct StaticOrder {
    int nM, nN, nwg, G, c;
    __host__ __device__ void init(int M, int N, int G_, int c_) { nM = M / BM; nN = N / BM; nwg = nM * nN; G = G_; c = c_; }
    __host__ __device__ bool next(int i, Unit& u) const {
        const long L = (long)i * G + c; if (L >= nwg) return false;
        int wgid = (int)L; { const int q = nwg / NXCD, r = nwg % NXCD, xcd = wgid % NXCD, off = wgid / NXCD; wgid = (xcd < r ? xcd * (q + 1) : r * (q + 1) + (xcd - r) * q) + off; }
        const int nig = WGM * nN, gid = wgid / nig, fm = gid * WGM, gsz = (nM - fm) < WGM ? (nM - fm) : WGM;
        u.pm = fm + ((wgid % nig) % gsz); u.pn = (wgid % nig) / gsz; return true;
    }
    __device__ __forceinline__ void a_ready(const Unit&) const {}
    __device__ __forceinline__ void done(const Unit&) const {}
};

__device__ __forceinline__ unsigned cvt_pk_bf16(float lo, float hi) { unsigned r; asm volatile("v_cvt_pk_bf16_f32 %0, %1, %2" : "=v"(r) : "v"(lo), "v"(hi)); return r; }
template <class Epi, class Sched, bool ALIGN_EPI = false, bool SP2 = false>
__device__ __forceinline__ void gemm_phase(PG8_LAS unsigned char* lds, const Gemm g, const Sched& S, const Epi& E) {
    const int tid = threadIdx.x, wid = __builtin_amdgcn_readfirstlane(tid >> 6), lane = tid & 63, wr = wid >> 2, wc = wid & 3, fr = lane & 15, fq = lane >> 4;
    const int K = g.K, nt = K / BK;
    unsigned voffA[2], voffB[2];
#pragma unroll
    for (int i = 0; i < 2; ++i) { int R, C; stage_rc(tid * 16 + i * 8192, R, C); const int Rb = Epi::PERM ? ((R & ~31) + perm32(R & 31)) : R;
        voffA[i] = (unsigned)(R * K + C) * 2u; voffB[i] = (unsigned)(Rb * K + C) * 2u; }
    const size_t kstep = (size_t)(BK * 2);
    const size_t hstep = (size_t)HALF * K * 2;
    const size_t tstep = 2 * hstep;
    const unsigned ldsw = (unsigned)wid * 1024u;
    const int aoff = lds_byte(wr * 64 + fr, fq * 8), boff = lds_byte(wc * 32 + fr, fq * 8);
#define PG8_SA(b, h) (((b) * 2 + (h)) * HTB)
#define PG8_SB(b, h) ((4 + (b) * 2 + (h)) * HTB)
#define PG8_STAGE(bufoff, gbase, voff) do { _Pragma("unroll") for (int _i = 0; _i < 2; ++_i) \
        __builtin_amdgcn_global_load_lds((const unsigned*)((const char*)(gbase) + (voff)[_i]), (PG8_LAS unsigned*)(lds + (bufoff) + ldsw + _i * 8192), 16, 0, 0); } while (0)
#define PG8_LDA(dst, b, h) do { _Pragma("unroll") for (int m = 0; m < 4; ++m) _Pragma("unroll") for (int k = 0; k < 2; ++k) dst[m][k] = *(const PG8_LAS bf16x8*)(lds + PG8_SA(b, h) + aoff + m * 2048 + k * 1024); } while (0)
#define PG8_LDB(dst, b, h) do { _Pragma("unroll") for (int n = 0; n < 2; ++n) _Pragma("unroll") for (int k = 0; k < 2; ++k) dst[n][k] = *(const PG8_LAS bf16x8*)(lds + PG8_SB(b, h) + boff + n * 2048 + k * 1024); } while (0)
#define PG8_MMA(ai, bj, At, Bt) do { __builtin_amdgcn_s_setprio(1); _Pragma("unroll") for (int m = 0; m < 4; ++m) _Pragma("unroll") for (int n = 0; n < 2; ++n) _Pragma("unroll") for (int k = 0; k < 2; ++k) \
        acc[ai][bj][m][n] = __builtin_amdgcn_mfma_f32_16x16x32_bf16(Bt[n][k], At[m][k], acc[ai][bj][m][n], 0, 0, 0); __builtin_amdgcn_s_setprio(0); } while (0)
#define PG8_WAIT_V(n) asm volatile("s_waitcnt vmcnt(" #n ")" ::: "memory")
#define PG8_WAIT_L(n) asm volatile("s_waitcnt lgkmcnt(" #n ")" ::: "memory")
#define PG8_BAR __builtin_amdgcn_s_barrier()
#define PG8_SCHED __builtin_amdgcn_sched_barrier(0)
    Unit cur, nxt; int ui = 0;
    if (!S.next(0, cur)) return;
    f32x4 acc[2][2][4][2];
#pragma unroll
    for (int a = 0; a < 2; ++a)
#pragma unroll
        for (int b = 0; b < 2; ++b)
#pragma unroll
            for (int m = 0; m < 4; ++m)
#pragma unroll
                for (int n = 0; n < 2; ++n) acc[a][b][m][n] = (f32x4){0.f, 0.f, 0.f, 0.f};
    bf16x8 At[4][2], B0[2][2], B1[2][2];
    const char* cA = (const char*)g.A + (size_t)cur.pm * tstep; const char* cB = (const char*)g.Bt + (size_t)cur.pn * tstep;
    S.a_ready(cur);
    if constexpr (SP2) {
        PG8_STAGE(PG8_SB(0, 0), cB, voffB); PG8_STAGE(PG8_SB(0, 1), cB + hstep, voffB); PG8_STAGE(PG8_SA(0, 0), cA, voffA); PG8_STAGE(PG8_SA(0, 1), cA + hstep, voffA);
        if (wr == 1) PG8_BAR;
        PG8_WAIT_V(2); PG8_BAR;
        PG8_STAGE(PG8_SB(1, 0), cB + kstep, voffB); PG8_STAGE(PG8_SA(1, 0), cA + kstep, voffA); PG8_STAGE(PG8_SB(1, 1), cB + hstep + kstep, voffB);
        PG8_WAIT_V(6); PG8_BAR;
    } else {
        PG8_STAGE(PG8_SB(0, 0), cB, voffB); PG8_STAGE(PG8_SA(0, 0), cA, voffA); PG8_STAGE(PG8_SB(0, 1), cB + hstep, voffB); PG8_STAGE(PG8_SA(0, 1), cA + hstep, voffA);
        if (wr == 1) PG8_BAR;
        PG8_WAIT_V(4); PG8_BAR;
        PG8_STAGE(PG8_SB(1, 0), cB + kstep, voffB); PG8_STAGE(PG8_SA(1, 0), cA + kstep, voffA); PG8_STAGE(PG8_SB(1, 1), cB + hstep + kstep, voffB);
        PG8_WAIT_V(6); PG8_BAR;
    }
    for (;;) {
        const bool has_next = S.next(ui + 1, nxt);
        const char* nA = has_next ? (const char*)g.A + (size_t)nxt.pm * tstep : cA; const char* nB = has_next ? (const char*)g.Bt + (size_t)nxt.pn * tstep : cB;
        for (int t = 0; t < nt; t += 2) {
            const bool last = (t == nt - 2);
            const char* a1 = cA + (size_t)(t + 1) * kstep;
            const char* a2 = last ? nA : cA + (size_t)(t + 2) * kstep; const char* b2 = last ? nB : cB + (size_t)(t + 2) * kstep;
            const char* a3 = a2 + kstep; const char* b3 = b2 + kstep;
            if (last && has_next) S.a_ready(nxt);
            if constexpr (SP2) {
            PG8_LDB(B0, 0, 0); PG8_LDB(B1, 0, 1); PG8_SCHED; PG8_LDA(At, 0, 0); PG8_STAGE(PG8_SA(1, 1), a1 + hstep, voffA);
            PG8_WAIT_V(8); PG8_WAIT_L(0); PG8_BAR; PG8_MMA(0, 0, At, B0); PG8_MMA(0, 1, At, B1); PG8_BAR; PG8_SCHED;
            PG8_LDA(At, 0, 1); PG8_STAGE(PG8_SB(0, 0), b2, voffB); PG8_STAGE(PG8_SB(0, 1), b2 + hstep, voffB); PG8_STAGE(PG8_SA(0, 0), a2, voffA);
            PG8_WAIT_V(8); PG8_WAIT_L(0); PG8_BAR; PG8_MMA(1, 0, At, B0); PG8_MMA(1, 1, At, B1); PG8_BAR; PG8_SCHED;
            PG8_LDB(B0, 1, 0); PG8_LDB(B1, 1, 1); PG8_SCHED; PG8_LDA(At, 1, 0); PG8_STAGE(PG8_SA(0, 1), a2 + hstep, voffA);
            PG8_WAIT_V(8); PG8_WAIT_L(0); PG8_BAR; PG8_MMA(0, 0, At, B0); PG8_MMA(0, 1, At, B1); PG8_BAR; PG8_SCHED;
            PG8_LDA(At, 1, 1); PG8_STAGE(PG8_SB(1, 0), b3, voffB); PG8_STAGE(PG8_SB(1, 1), b3 + hstep, voffB); PG8_STAGE(PG8_SA(1, 0), a3, voffA);
            PG8_WAIT_V(8); PG8_WAIT_L(0); PG8_BAR; PG8_MMA(1, 0, At, B0); PG8_MMA(1, 1, At, B1); PG8_BAR; PG8_SCHED;
            } else {
            PG8_LDB(B0, 0, 0); PG8_SCHED; PG8_LDA(At, 0, 0); PG8_STAGE(PG8_SA(1, 1), a1 + hstep, voffA);
            PG8_WAIT_L(8); PG8_BAR; PG8_WAIT_L(0); PG8_MMA(0, 0, At, B0); PG8_BAR; PG8_SCHED;
            PG8_LDB(B1, 0, 1); PG8_STAGE(PG8_SB(0, 0), b2, voffB);
            PG8_BAR; PG8_WAIT_L(0); PG8_MMA(0, 1, At, B1); PG8_BAR;
            PG8_LDA(At, 0, 1); PG8_STAGE(PG8_SA(0, 0), a2, voffA);
            PG8_BAR; PG8_WAIT_L(0); PG8_MMA(1, 0, At, B0); PG8_BAR; PG8_SCHED;
            PG8_STAGE(PG8_SB(0, 1), b2 + hstep, voffB);
            PG8_WAIT_V(6); PG8_BAR; PG8_MMA(1, 1, At, B1); PG8_BAR;
            PG8_LDB(B0, 1, 0); PG8_SCHED; PG8_LDA(At, 1, 0); PG8_STAGE(PG8_SA(0, 1), a2 + hstep, voffA);
            PG8_WAIT_L(8); PG8_BAR; PG8_WAIT_L(0); PG8_MMA(0, 0, At, B0); PG8_BAR; PG8_SCHED;
            PG8_LDB(B1, 1, 1); PG8_STAGE(PG8_SB(1, 0), b3, voffB);
            PG8_BAR; PG8_WAIT_L(0); PG8_MMA(0, 1, At, B1); PG8_BAR;
            PG8_LDA(At, 1, 1); PG8_STAGE(PG8_SA(1, 0), a3, voffA);
            PG8_BAR; PG8_WAIT_L(0); PG8_MMA(1, 0, At, B0); PG8_BAR; PG8_SCHED;
            PG8_STAGE(PG8_SB(1, 1), b3 + hstep, voffB);
            PG8_WAIT_V(6); PG8_BAR; PG8_MMA(1, 1, At, B1); PG8_BAR;
            }
        }
        if constexpr (ALIGN_EPI) { if (wr == 0) PG8_BAR; }
        if constexpr (!Epi::AFTER_DRAIN) { E(acc, cur, wr, wc, fr, fq); S.done(cur); }
        if (!has_next) break;
#pragma unroll
        for (int a = 0; a < 2; ++a)
#pragma unroll
            for (int b = 0; b < 2; ++b)
#pragma unroll
                for (int m = 0; m < 4; ++m)
#pragma unroll
                    for (int n = 0; n < 2; ++n) acc[a][b][m][n] = (f32x4){0.f, 0.f, 0.f, 0.f};
        cur = nxt; cA = nA; cB = nB; ++ui;
        if constexpr (ALIGN_EPI) { if (wr == 1) PG8_BAR; }
    }
    PG8_WAIT_V(0);
    if constexpr (!ALIGN_EPI) { if (wr == 0) PG8_BAR; }
    PG8_BAR;
    if constexpr (Epi::AFTER_DRAIN) { E.fused(acc, cur, wr, wc, fr, fq, lds, wid, lane); S.done(cur); }
#undef PG8_SA
#undef PG8_SB
#undef PG8_STAGE
#undef PG8_LDA
#undef PG8_LDB
#undef PG8_MMA
#undef PG8_WAIT_V
#undef PG8_WAIT_L
#undef PG8_BAR
#undef PG8_SCHED
}
}

using pg8::bf16_t; using pg8::bf16x8; using pg8::f32x4; using pg8::u32x4;
typedef __bf16 bf16v2_t __attribute__((ext_vector_type(2)));
typedef float f32v2_t __attribute__((ext_vector_type(2)));
__device__ __forceinline__ unsigned cvt_pk_bf16(float lo, float hi) { const f32v2_t v = {lo, hi}; const bf16v2_t b = __builtin_convertvector(v, bf16v2_t); return __builtin_bit_cast(unsigned, b); }
#define LAS __attribute__((address_space(3)))
typedef unsigned u32x2 __attribute__((ext_vector_type(2)));

#ifndef MK_LAUNCH_PER_PHASE
#define MK_LAUNCH_PER_PHASE 0
#endif

constexpr int T = 49152, D = 1024, FF = 2816, SEQL = 8192, TP = 32768, NCHUNK = 384;
constexpr float EPS = 1e-6f;
constexpr float LOG2E = 1.44269504088896f;
constexpr size_t MiB = 1u << 20;
constexpr size_t WS_ZQ = 0;
constexpr size_t WS_XBC = 192 * MiB;
constexpr size_t WS_KV = 336 * MiB;
constexpr size_t WS_DT = 384 * MiB;
constexpr size_t WS_XNB = 390 * MiB;
constexpr size_t WS_WIN = 486 * MiB;
constexpr size_t WS_WOUT = 495 * MiB;
constexpr size_t WS_SMALL = 499 * MiB;
constexpr size_t WS_CHDEC = 509 * MiB;
constexpr size_t WS_END = 510 * MiB;
constexpr size_t WS_H = 0;
constexpr size_t WS_WFA = 264 * MiB;
constexpr size_t WS_WFD = 275 * MiB;
constexpr int LDS_BYTES = 147456;

struct Params { const float* in[23]; float* out; unsigned char* ws; };

__device__ __forceinline__ float bflo(unsigned w) { return __uint_as_float(w << 16); }
__device__ __forceinline__ float bfhi(unsigned w) { return __uint_as_float(w & 0xffff0000u); }
__device__ __forceinline__ float silu_f(float v) { return v * __builtin_amdgcn_rcpf(1.f + __expf(-v)); }
__device__ __forceinline__ float wave_sum(float v) {
#pragma unroll
    for (int o = 1; o < 64; o <<= 1) v += __shfl_xor(v, o);
    return v;
}
__device__ __forceinline__ float row_rs(const float* part, int row) {
    const f32x4* q = (const f32x4*)(part + (size_t)row * 16); const f32x4 a = q[0], b = q[1], c = q[2], d = q[3];
    const float s = (((a[0] + a[1]) + (a[2] + a[3])) + ((b[0] + b[1]) + (b[2] + b[3]))) + (((c[0] + c[1]) + (c[2] + c[3])) + ((d[0] + d[1]) + (d[2] + d[3])));
    return rsqrtf(s * (1.f / D) + EPS);
}
__device__ __forceinline__ u32x4 pk8(const f32x4 a, const f32x4 b) { u32x4 w; w.x = cvt_pk_bf16(a[0], a[1]); w.y = cvt_pk_bf16(a[2], a[3]); w.z = cvt_pk_bf16(b[0], b[1]); w.w = cvt_pk_bf16(b[2], b[3]); return w; }
__device__ __forceinline__ u32x2 pk4(const f32x4 a) { u32x2 w; w.x = cvt_pk_bf16(a[0], a[1]); w.y = cvt_pk_bf16(a[2], a[3]); return w; }
__device__ __forceinline__ f32x4 mfma16(const bf16x8 a, const bf16x8 b, const f32x4 c) { return __builtin_amdgcn_mfma_f32_16x16x32_bf16(a, b, c, 0, 0, 0); }

struct EpiGateUp {
    static constexpr bool PERM = true, AFTER_DRAIN = false;
    bf16_t* H; const float* rowss;
    __device__ __forceinline__ void operator()(const f32x4 (&acc)[2][2][4][2], const pg8::Unit& u, int wr, int wc, int fr, int fq) const {
        const int row0 = u.pm * 256 + wr * 64 + fr, col0 = u.pn * 128 + wc * 32 + 8 * fq;
#pragma unroll
        for (int ai = 0; ai < 2; ++ai)
#pragma unroll
            for (int m = 0; m < 4; ++m) {
                const int row = row0 + ai * 128 + m * 16;
                const float rs = rowss ? row_rs(rowss, row) : 1.f;
                f32x4 h0, h1;
#pragma unroll
                for (int j = 0; j < 4; ++j) { h0[j] = silu_f(acc[ai][0][m][0][j] * rs) * (acc[ai][1][m][0][j] * rs); h1[j] = silu_f(acc[ai][0][m][1][j] * rs) * (acc[ai][1][m][1][j] * rs); }
                *(u32x4*)(H + (size_t)row * FF + col0) = pk8(h0, h1);
            }
    }
};
struct EpiDown1 {
    static constexpr bool PERM = true, AFTER_DRAIN = false;
    const float* xp; const float* xs; bf16_t* delta; bf16_t* x1b; float* rowss;
    __device__ __forceinline__ void operator()(const f32x4 (&acc)[2][2][4][2], const pg8::Unit& u, int wr, int wc, int fr, int fq) const {
        const int row0 = u.pm * 256 + wr * 64 + fr, col0 = u.pn * 256 + wc * 32 + 8 * fq;
#pragma unroll
        for (int ai = 0; ai < 2; ++ai)
#pragma unroll
            for (int m = 0; m < 4; ++m) {
                const int row = row0 + ai * 128 + m * 16;
                const float* xr = (row < TP ? xp + (size_t)row * D : xs + (size_t)(row - TP) * D) + col0;
                const size_t o = (size_t)row * D + col0; float ss = 0.f;
#pragma unroll
                for (int bj = 0; bj < 2; ++bj) {
                    const f32x4 xa = *(const f32x4*)(xr + bj * 128), xb = *(const f32x4*)(xr + bj * 128 + 4);
                    const f32x4 d0 = acc[ai][bj][m][0] * 0.5f, d1 = acc[ai][bj][m][1] * 0.5f, y0 = xa + d0, y1 = xb + d1;
#pragma unroll
                    for (int j = 0; j < 4; ++j) ss += y0[j] * y0[j] + y1[j] * y1[j];
                    *(u32x4*)(delta + o + bj * 128) = pk8(d0, d1); *(u32x4*)(x1b + o + bj * 128) = pk8(y0, y1);
                }
                ss += __shfl_xor(ss, 16); ss += __shfl_xor(ss, 32);
                if (fq == 0) rowss[(size_t)row * 16 + u.pn * 4 + wc] = ss;
            }
    }
};
struct EpiInProj {
    static constexpr bool PERM = true, AFTER_DRAIN = false;
    bf16_t* zq; bf16_t* xbc; bf16_t* kv; const float* rowss;
    __device__ __forceinline__ void operator()(const f32x4 (&acc)[2][2][4][2], const pg8::Unit& u, int wr, int wc, int fr, int fq) const {
        const int row0 = u.pm * 256 + wr * 64 + fr, pn = u.pn;
        bf16_t* base; int pitch, cb;
        if (pn < 4) { base = zq; pitch = 2048; cb = pn * 256; } else if (pn < 10) { base = xbc; pitch = 1536; cb = (pn - 4) * 256; }
        else if (pn < 14) { base = zq; pitch = 2048; cb = 1024 + (pn - 10) * 256; } else { base = kv; pitch = 512; cb = (pn - 14) * 256; }
        const int col0 = cb + wc * 32 + 8 * fq;
#pragma unroll
        for (int ai = 0; ai < 2; ++ai)
#pragma unroll
            for (int m = 0; m < 4; ++m) {
                const int row = row0 + ai * 128 + m * 16;
                const float rs = row_rs(rowss, row);
#pragma unroll
                for (int bj = 0; bj < 2; ++bj) *(u32x4*)(base + (size_t)row * pitch + col0 + bj * 128) = pk8(acc[ai][bj][m][0] * rs, acc[ai][bj][m][1] * rs);
            }
    }
};
struct EpiOutProj {
    static constexpr bool PERM = true, AFTER_DRAIN = false;
    const float* xp; const float* xs; bf16_t* dx; float* out; float* rowss;
    __device__ __forceinline__ void operator()(const f32x4 (&acc)[2][2][4][2], const pg8::Unit& u, int wr, int wc, int fr, int fq) const {
        const int row0 = u.pm * 256 + wr * 64 + fr, col0 = u.pn * 256 + wc * 32 + 8 * fq;
#pragma unroll
        for (int ai = 0; ai < 2; ++ai)
#pragma unroll
            for (int m = 0; m < 4; ++m) {
                const int row = row0 + ai * 128 + m * 16;
                const float* xr = (row < TP ? xp + (size_t)row * D : xs + (size_t)(row - TP) * D) + col0;
                const size_t o = (size_t)row * D + col0; float ss = 0.f;
#pragma unroll
                for (int bj = 0; bj < 2; ++bj) {
                    const f32x4 xa = *(const f32x4*)(xr + bj * 128), xb = *(const f32x4*)(xr + bj * 128 + 4);
                    const u32x4 dv = *(const u32x4*)(dx + o + bj * 128);
                    const f32x4 da = {bflo(dv.x), bfhi(dv.x), bflo(dv.y), bfhi(dv.y)}, db = {bflo(dv.z), bfhi(dv.z), bflo(dv.w), bfhi(dv.w)};
                    const f32x4 y0 = xa + da + acc[ai][bj][m][0], y1 = xb + db + acc[ai][bj][m][1];
#pragma unroll
                    for (int j = 0; j < 4; ++j) ss += y0[j] * y0[j] + y1[j] * y1[j];
                    *(f32x4*)(out + o + bj * 128) = y0; *(f32x4*)(out + o + bj * 128 + 4) = y1;
                    *(u32x4*)(dx + o + bj * 128) = pk8(y0, y1);
                }
                ss += __shfl_xor(ss, 16); ss += __shfl_xor(ss, 32);
                if (fq == 0) rowss[(size_t)row * 16 + u.pn * 4 + wc] = ss;
            }
    }
};
struct EpiDown2 {
    static constexpr bool PERM = true, AFTER_DRAIN = false;
    float* out; float* rowss;
    __device__ __forceinline__ void operator()(const f32x4 (&acc)[2][2][4][2], const pg8::Unit& u, int wr, int wc, int fr, int fq) const {
        const int row0 = u.pm * 256 + wr * 64 + fr, col0 = u.pn * 256 + wc * 32 + 8 * fq;
#pragma unroll
        for (int ai = 0; ai < 2; ++ai)
#pragma unroll
            for (int m = 0; m < 4; ++m) {
                const int row = row0 + ai * 128 + m * 16;
                const size_t o = (size_t)row * D + col0; float ss = 0.f;
#pragma unroll
                for (int bj = 0; bj < 2; ++bj) {
                    const f32x4 y0 = *(const f32x4*)(out + o + bj * 128) + acc[ai][bj][m][0] * 0.5f, y1 = *(const f32x4*)(out + o + bj * 128 + 4) + acc[ai][bj][m][1] * 0.5f;
#pragma unroll
                    for (int j = 0; j < 4; ++j) ss += y0[j] * y0[j] + y1[j] * y1[j];
                    *(f32x4*)(out + o + bj * 128) = y0; *(f32x4*)(out + o + bj * 128 + 4) = y1;
                }
                ss += __shfl_xor(ss, 16); ss += __shfl_xor(ss, 32);
                if (fq == 0) rowss[(size_t)row * 16 + u.pn * 4 + wc] = ss;
            }
    }
};

__device__ __forceinline__ void transpose_item(const float* W, int N, int k0, int n0, const float* kscale, bf16_t* WT, int Kp, int drow0, LAS float* scr, int lane) {
#pragma unroll 8
    for (int i = 0; i < 32; ++i) { const int kk = 2 * i + (lane >> 5); float v = W[(size_t)(k0 + kk) * N + n0 + (lane & 31)]; if (kscale) v *= kscale[k0 + kk]; scr[kk * 33 + (lane & 31)] = v; }
    asm volatile("s_waitcnt lgkmcnt(0)" ::: "memory");
    const int c = lane & 7;
#pragma unroll
    for (int j = 0; j < 4; ++j) { const int n = (lane >> 3) + 8 * j; const LAS float* s = scr + (8 * c) * 33 + n;
        u32x4 o; o.x = cvt_pk_bf16(s[0 * 33], s[1 * 33]); o.y = cvt_pk_bf16(s[2 * 33], s[3 * 33]); o.z = cvt_pk_bf16(s[4 * 33], s[5 * 33]); o.w = cvt_pk_bf16(s[6 * 33], s[7 * 33]);
        *(u32x4*)(WT + (size_t)(drow0 + n) * Kp + k0 + 8 * c) = o; }
    asm volatile("s_waitcnt lgkmcnt(0)" ::: "memory");
}
__device__ __forceinline__ void ffn_weight_item(const float* wg, const float* wu, const float* wd, const float* kscale, unsigned char* ws, LAS float* scr, int it, int lane) {
    bf16_t* WFA = (bf16_t*)(ws + WS_WFA); bf16_t* WFD = (bf16_t*)(ws + WS_WFD);
    if (it < 2816) { const int which = it / 1408, r = it % 1408, kb = r / 88, nb = r % 88, n0 = nb * 32;
        transpose_item(which ? wu : wg, FF, kb * 64, n0, kscale, WFA, D, (n0 >> 7) * 256 + (n0 & 127) + which * 128, scr, lane); }
    else { const int r = it - 2816, kb = r / 32, nb = r % 32; transpose_item(wd, D, kb * 64, nb * 32, nullptr, WFD, FF, nb * 32, scr, lane); }
}
constexpr int FFN_W_ITEMS = 3 * 1408;

__device__ __forceinline__ void phase0(const Params& p, LAS unsigned char* lds, int gw, int ngw, int lane, int wave) {
    LAS float* scr = (LAS float*)(lds + wave * 16384);
    constexpr int I_IN = 16 * 129, I_O = 32 * 32, NIT = FFN_W_ITEMS + I_IN + I_O;
    for (int it = gw; it < NIT; it += ngw) {
        if (it < FFN_W_ITEMS) { ffn_weight_item(p.in[3], p.in[4], p.in[5], nullptr, p.ws, scr, it, lane); continue; }
        int r = it - FFN_W_ITEMS;
        if (r < I_IN) { const int kb = r / 129, nb = r % 129, n0 = nb * 32; const int drow0 = n0 < 2560 ? n0 : (n0 == 2560 ? 4096 : n0 - 32);
            transpose_item(p.in[7], 4128, kb * 64, n0, p.in[6], (bf16_t*)(p.ws + WS_WIN), D, drow0, scr, lane); continue; }
        r -= I_IN;
        { const int kb = r / 32, nb = r % 32; transpose_item(p.in[17], D, kb * 64, nb * 32, nullptr, (bf16_t*)(p.ws + WS_WOUT), 2048, nb * 32, scr, lane); }
    }
    const float* nw = p.in[2]; bf16_t* XN = (bf16_t*)(p.ws + WS_XNB);
    f32x4 wv[4];
#pragma unroll
    for (int j = 0; j < 4; ++j) wv[j] = *(const f32x4*)(nw + 4 * lane + 256 * j);
    for (int m = gw; m < T; m += ngw) {
        const float* xr = (m < TP ? p.in[0] + (size_t)m * D : p.in[1] + (size_t)(m - TP) * D) + 4 * lane;
        f32x4 v[4]; float s = 0.f;
#pragma unroll
        for (int j = 0; j < 4; ++j) { v[j] = *(const f32x4*)(xr + 256 * j); s += (v[j][0] * v[j][0] + v[j][1] * v[j][1]) + (v[j][2] * v[j][2] + v[j][3] * v[j][3]); }
        const float rs = rsqrtf(wave_sum(s) * (1.f / D) + EPS);
#pragma unroll
        for (int j = 0; j < 4; ++j) *(u32x2*)(XN + (size_t)m * D + 4 * lane + 256 * j) = pk4(v[j] * rs * wv[j]);
    }
}

__device__ __forceinline__ void dt_phase(const Params& p, const bf16_t* x1b, int gw, int ngw, int lane) {
    const bf16_t* Wdt = (const bf16_t*)(p.ws + WS_WIN) + (size_t)4096 * D;
    const float* rowss = (const float*)(p.ws + WS_SMALL); float* DT = (float*)(p.ws + WS_DT);
    const int fr = lane & 15, fq = lane >> 4;
    for (int t16 = gw; t16 < T / 16; t16 += ngw) {
        const int row = t16 * 16 + fr;
        const bf16_t* ap = x1b + (size_t)row * D + 8 * fq; const bf16_t* bp = Wdt + (size_t)fr * D + 8 * fq;
        f32x4 acc0 = {0.f, 0.f, 0.f, 0.f}, acc1 = acc0;
#pragma unroll 8
        for (int ks = 0; ks < 32; ++ks) { const bf16x8 a = *(const bf16x8*)(ap + ks * 32), b0 = *(const bf16x8*)(bp + ks * 32), b1 = *(const bf16x8*)(bp + 16 * D + ks * 32);
            acc0 = mfma16(b0, a, acc0); acc1 = mfma16(b1, a, acc1); }
        const float rs = row_rs(rowss, row);
#pragma unroll
        for (int nt = 0; nt < 2; ++nt) { const f32x4 a = nt ? acc1 : acc0; const int col = nt * 16 + 4 * fq; const float* bias = (nt ? p.in[11] : p.in[10]) + 4 * fq; f32x4 o;
#pragma unroll
            for (int j = 0; j < 4; ++j) { const float v = a[j] * rs + bias[j]; o[j] = v > 20.f ? v : log1pf(__expf(v)); }
            *(f32x4*)(DT + (size_t)row * 32 + col) = o; }
    }
}

struct ConvW { f32x4 w[5][2]; f32x4 b[2]; };
__device__ __forceinline__ void load_convw(ConvW& cw, const float* conv_w, const float* conv_b, int c) {
#pragma unroll
    for (int k = 0; k < 5; ++k) { cw.w[k][0] = *(const f32x4*)(conv_w + k * 1536 + c); cw.w[k][1] = *(const f32x4*)(conv_w + k * 1536 + c + 4); }
    cw.b[0] = *(const f32x4*)(conv_b + c); cw.b[1] = *(const f32x4*)(conv_b + c + 4);
}
__device__ __forceinline__ void conv8x2(const bf16_t* xbc, int row, int lo, int hi, int c, const ConvW& cw, f32x4& o0a, f32x4& o0b, f32x4& o1a, f32x4& o1b) {
    f32x4 xa[6], xb[6];
#pragma unroll
    for (int k = 0; k < 6; ++k) { const int r = row + k - 2; const bool ok = (r >= lo) && (r < hi); const int rc = ok ? r : row;
        u32x4 v = *(const u32x4*)(xbc + (size_t)rc * 1536 + c); if (!ok) v = (u32x4){0u, 0u, 0u, 0u};
        xa[k] = (f32x4){bflo(v.x), bfhi(v.x), bflo(v.y), bfhi(v.y)}; xb[k] = (f32x4){bflo(v.z), bfhi(v.z), bflo(v.w), bfhi(v.w)}; }
    o0a = cw.b[0]; o0b = cw.b[1]; o1a = cw.b[0]; o1b = cw.b[1];
#pragma unroll
    for (int k = 0; k < 5; ++k) { o0a += xa[k] * cw.w[k][0]; o0b += xb[k] * cw.w[k][1]; o1a += xa[k + 1] * cw.w[k][0]; o1b += xb[k + 1] * cw.w[k][1]; }
#pragma unroll
    for (int j = 0; j < 4; ++j) { o0a[j] = silu_f(o0a[j]); o0b[j] = silu_f(o0b[j]); o1a[j] = silu_f(o1a[j]); o1b[j] = silu_f(o1b[j]); }
}

__device__ __forceinline__ void ssd_states_item(const Params& p, LAS unsigned char* lds, int cidx, int g) {
    int tid = threadIdx.x; asm volatile("" : "+v"(tid));
    const int lane = tid & 63, wave = __builtin_amdgcn_readfirstlane(tid >> 6), fr = lane & 15, fq = lane >> 4;
    LAS float* DTs = (LAS float*)lds;
    LAS float* Ws = DTs + 2048;
    LAS bf16_t* BT = (LAS bf16_t*)(lds + 16384);
    LAS bf16_t* XTf = BT + 128 * 136;
    LAS bf16_t* XTb = XTf + 64 * 136;
    const bf16_t* XBC = (const bf16_t*)(p.ws + WS_XBC); const float* DT = (const float*)(p.ws + WS_DT);
    float* CHDEC = (float*)(p.ws + WS_CHDEC); bf16_t* ST = (bf16_t*)p.out;
    const int t0 = cidx * 128, lo = (cidx >> 6) * SEQL, hi = lo + SEQL;
    __syncthreads();
    for (int i = tid; i < 2048; i += 512) { const int l = i >> 4, j = i & 15; DTs[j * 128 + l] = DT[(size_t)(t0 + l) * 32 + (j >> 3) * 16 + g * 8 + (j & 7)]; }
#pragma unroll 1
    for (int rep = 0; rep < 2; ++rep) { const int c8 = wave + 8 * rep; ConvW cw; load_convw(cw, p.in[8], p.in[9], 1024 + g * 128 + c8 * 8);
        f32x4 a0, b0, a1, b1; conv8x2(XBC, t0 + 2 * lane, lo, hi, 1024 + g * 128 + c8 * 8, cw, a0, b0, a1, b1);
#pragma unroll
        for (int i = 0; i < 4; ++i) { *(LAS unsigned*)(BT + (c8 * 8 + i) * 136 + 2 * lane) = cvt_pk_bf16(a0[i], a1[i]); *(LAS unsigned*)(BT + (c8 * 8 + 4 + i) * 136 + 2 * lane) = cvt_pk_bf16(b0[i], b1[i]); } }
    __syncthreads();
    if (tid < 16) { const int dir = tid >> 3, h = tid & 7; const float a = -__expf((dir ? p.in[13] : p.in[12])[g * 8 + h]);
        LAS float* d = DTs + tid * 128; LAS float* w = Ws + tid * 128; float run = 0.f;
        if (dir == 0) { for (int l = 0; l < 128; ++l) { run += d[l] * a; w[l] = run; } } else { for (int l = 127; l >= 0; --l) { run += d[l] * a; w[l] = run; } }
        for (int l = 0; l < 128; ++l) w[l] = d[l] * __expf(run - w[l]);
        CHDEC[(cidx * 2 + dir) * 16 + g * 8 + h] = __expf(run); }
    __syncthreads();
#pragma unroll 1
    for (int h = 0; h < 8; ++h) {
        { const int c8 = wave, col = g * 512 + h * 64 + c8 * 8; ConvW cw; load_convw(cw, p.in[8], p.in[9], col);
          f32x4 a0, b0, a1, b1; conv8x2(XBC, t0 + 2 * lane, lo, hi, col, cw, a0, b0, a1, b1);
          const float wf0 = Ws[h * 128 + 2 * lane], wf1 = Ws[h * 128 + 2 * lane + 1], wb0 = Ws[(8 + h) * 128 + 2 * lane], wb1 = Ws[(8 + h) * 128 + 2 * lane + 1];
#pragma unroll
          for (int i = 0; i < 4; ++i) {
              *(LAS unsigned*)(XTf + (c8 * 8 + i) * 136 + 2 * lane) = cvt_pk_bf16(a0[i] * wf0, a1[i] * wf1); *(LAS unsigned*)(XTf + (c8 * 8 + 4 + i) * 136 + 2 * lane) = cvt_pk_bf16(b0[i] * wf0, b1[i] * wf1);
              *(LAS unsigned*)(XTb + (c8 * 8 + i) * 136 + 2 * lane) = cvt_pk_bf16(a0[i] * wb0, a1[i] * wb1); *(LAS unsigned*)(XTb + (c8 * 8 + 4 + i) * 136 + 2 * lane) = cvt_pk_bf16(b0[i] * wb0, b1[i] * wb1); } }
        __syncthreads();
        { const int dir = wave >> 2, pt = wave & 3; const LAS bf16_t* A = (dir ? XTb : XTf) + (pt * 16 + fr) * 136 + 8 * fq; const LAS bf16_t* B = BT + fr * 136 + 8 * fq;
          f32x4 acc[8];
#pragma unroll
          for (int nt = 0; nt < 8; ++nt) acc[nt] = (f32x4){0.f, 0.f, 0.f, 0.f};
#pragma unroll
          for (int ks = 0; ks < 4; ++ks) { const bf16x8 a = *(const LAS bf16x8*)(A + ks * 32);
#pragma unroll
              for (int nt = 0; nt < 8; ++nt) acc[nt] = mfma16(*(const LAS bf16x8*)(B + nt * 16 * 136 + ks * 32), a, acc[nt]); }
          bf16_t* dst = ST + ((size_t)((cidx * 2 + dir) * 16 + g * 8 + h) * 64 + pt * 16 + fr) * 128 + 4 * fq;
#pragma unroll
#if defined(DBG_ST) && DBG_ST == 1
          for (int nt = 0; nt < 8; ++nt) *(u32x2*)(dst + nt * 16) = (u32x2){0x3f803f80u, 0x3f803f80u}; }
#else
          for (int nt = 0; nt < 8; ++nt) *(u32x2*)(dst + nt * 16) = pk4(acc[nt]); }
#endif
        __syncthreads();
    }
}

__device__ __forceinline__ void ssd_scan_phase(const Params& p) {
    bf16_t* ST = (bf16_t*)p.out; const float* CHDEC = (const float*)(p.ws + WS_CHDEC);
    for (int it = blockIdx.x * 512 + threadIdx.x; it < 6 * 2 * 16 * 1024; it += gridDim.x * 512) {
        const int e8 = it & 1023, head = (it >> 10) & 15, dir = (it >> 14) & 1, seq = it >> 15;
        f32x4 c0 = {0.f, 0.f, 0.f, 0.f}, c1 = c0;
#pragma unroll 1
        for (int sb = 0; sb < 8; ++sb) {
            u32x4 v[8]; float dec[8];
#pragma unroll
            for (int k = 0; k < 8; ++k) { const int step = sb * 8 + k, cidx = seq * 64 + (dir ? 63 - step : step);
                v[k] = *(const u32x4*)(ST + ((size_t)((cidx * 2 + dir) * 16 + head) * 8192) + e8 * 8); dec[k] = CHDEC[(cidx * 2 + dir) * 16 + head]; }
#pragma unroll
            for (int k = 0; k < 8; ++k) { const int step = sb * 8 + k, cidx = seq * 64 + (dir ? 63 - step : step);
                *(u32x4*)(ST + ((size_t)((cidx * 2 + dir) * 16 + head) * 8192) + e8 * 8) = pk8(c0, c1);
                c0 = c0 * dec[k] + (f32x4){bflo(v[k].x), bfhi(v[k].x), bflo(v[k].y), bfhi(v[k].y)}; c1 = c1 * dec[k] + (f32x4){bflo(v[k].z), bfhi(v[k].z), bflo(v[k].w), bfhi(v[k].w)}; }
        }
    }
}

__device__ __forceinline__ void ssd_out_item(const Params& p, LAS unsigned char* lds, int cidx, int g) {
    int tid = threadIdx.x; asm volatile("" : "+v"(tid));
    const int lane = tid & 63, wave = __builtin_amdgcn_readfirstlane(tid >> 6), fr = lane & 15, fq = lane >> 4;
    LAS float* DTF = (LAS float*)lds; LAS float* DTB = DTF + 1024; LAS float* CSF = DTB + 1024; LAS float* SFB = CSF + 1024;
    LAS bf16_t* Cm = (LAS bf16_t*)(lds + 16384);
    LAS bf16_t* Bm = Cm + 128 * 136;
    LAS bf16_t* XT = Bm + 128 * 136;
    LAS bf16_t* PF = XT + 64 * 136; LAS bf16_t* PB = PF + 64 * 136;
    const bf16_t* XBC = (const bf16_t*)(p.ws + WS_XBC); const float* DT = (const float*)(p.ws + WS_DT);
    const bf16_t* ST = (const bf16_t*)p.out; bf16_t* ZQ = (bf16_t*)(p.ws + WS_ZQ);
    const int t0 = cidx * 128, lo = (cidx >> 6) * SEQL, hi = lo + SEQL;
    __syncthreads();
    for (int i = tid; i < 2048; i += 512) { const int l = i >> 4, j = i & 15; DTF[j * 128 + l] = DT[(size_t)(t0 + l) * 32 + (j >> 3) * 16 + g * 8 + (j & 7)]; }
#pragma unroll 1
    for (int rep = 0; rep < 4; ++rep) { const int c8 = wave + 8 * (rep & 1), isC = rep >> 1, col = 1024 + isC * 256 + g * 128 + c8 * 8; ConvW cw; load_convw(cw, p.in[8], p.in[9], col);
        f32x4 a0, b0, a1, b1; conv8x2(XBC, t0 + 2 * lane, lo, hi, col, cw, a0, b0, a1, b1);
        LAS bf16_t* dstm = (isC ? Cm : Bm) + (2 * lane) * 136 + c8 * 8;
        *(LAS u32x4*)dstm = pk8(a0, b0); *(LAS u32x4*)(dstm + 136) = pk8(a1, b1); }
    __syncthreads();
    if (tid < 16) { const int dir = tid >> 3, h = tid & 7; const float a = -__expf((dir ? p.in[13] : p.in[12])[g * 8 + h]);
        LAS float* d = DTF + tid * 128; LAS float* w = (dir ? SFB : CSF) + h * 128; float run = 0.f;
        if (dir == 0) { for (int l = 0; l < 128; ++l) { run += d[l] * a; w[l] = run; } } else { for (int l = 127; l >= 0; --l) { run += d[l] * a; w[l] = run; } } }
    f32x4 cb[8];
    { const LAS bf16_t* A = Cm + (wave * 16 + fr) * 136 + 8 * fq; const LAS bf16_t* B = Bm + fr * 136 + 8 * fq;
#pragma unroll
      for (int nt = 0; nt < 8; ++nt) cb[nt] = (f32x4){0.f, 0.f, 0.f, 0.f};
#pragma unroll
      for (int ks = 0; ks < 4; ++ks) { const bf16x8 a = *(const LAS bf16x8*)(A + ks * 32);
#pragma unroll
          for (int nt = 0; nt < 8; ++nt) cb[nt] = mfma16(*(const LAS bf16x8*)(B + nt * 16 * 136 + ks * 32), a, cb[nt]); } }
    const int l = wave * 16 + fr; const size_t zrow = (size_t)(t0 + l) * 2048 + g * 512;
    float ss = 0.f;
#pragma unroll 1
    for (int h = 0; h < 8; ++h) {
        __syncthreads();
        { const int c8 = wave, col = g * 512 + h * 64 + c8 * 8; ConvW cw; load_convw(cw, p.in[8], p.in[9], col);
          f32x4 a0, b0, a1, b1; conv8x2(XBC, t0 + 2 * lane, lo, hi, col, cw, a0, b0, a1, b1);
#pragma unroll
          for (int i = 0; i < 4; ++i) { *(LAS unsigned*)(XT + (c8 * 8 + i) * 136 + 2 * lane) = cvt_pk_bf16(a0[i], a1[i]); *(LAS unsigned*)(XT + (c8 * 8 + 4 + i) * 136 + 2 * lane) = cvt_pk_bf16(b0[i], b1[i]); } }
        asm volatile("" ::: "memory");
        for (int i = tid; i < 2048; i += 512) { const int which = i >> 10, r = (i >> 4) & 63, c = i & 15;
            *(LAS u32x4*)((which ? PB : PF) + r * 136 + c * 8) = *(const u32x4*)(ST + ((size_t)((cidx * 2 + which) * 16 + g * 8 + h) * 64 + r) * 128 + c * 8); }
        asm volatile("" ::: "memory");
        const float csl = CSF[h * 128 + l], sbl = SFB[h * 128 + l], dtl = DTF[h * 128 + l] + DTB[h * 128 + l], dsk = p.in[14][g * 8 + h];
#pragma unroll
        for (int nt = 0; nt < 8; ++nt) { const int s0 = nt * 16 + 4 * fq;
            const f32x4 cs4 = *(const LAS f32x4*)(CSF + h * 128 + s0), df4 = *(const LAS f32x4*)(DTF + h * 128 + s0), sb4 = *(const LAS f32x4*)(SFB + h * 128 + s0), db4 = *(const LAS f32x4*)(DTB + h * 128 + s0);
            f32x4 gv;
#pragma unroll
            for (int r = 0; r < 4; ++r) { const int s = s0 + r; const float mm = s < l ? __expf(csl - cs4[r]) * df4[r] : (s > l ? __expf(sbl - sb4[r]) * db4[r] : dtl); gv[r] = cb[nt][r] * mm + (s == l ? dsk : 0.f); }
            *(LAS u32x2*)(Bm + l * 136 + s0) = pk4(gv); asm volatile("" ::: "memory"); }
        __syncthreads();
        f32x4 aY[4], aF[4], aB[4];
#pragma unroll
        for (int d = 0; d < 4; ++d) { aY[d] = (f32x4){0.f, 0.f, 0.f, 0.f}; aF[d] = aY[d]; aB[d] = aY[d]; }
#pragma unroll
        for (int ks = 0; ks < 4; ++ks) { const bf16x8 ag = *(const LAS bf16x8*)(Bm + l * 136 + ks * 32 + 8 * fq), ac = *(const LAS bf16x8*)(Cm + l * 136 + ks * 32 + 8 * fq);
#pragma unroll
            for (int d = 0; d < 4; ++d) { const int bo = (d * 16 + fr) * 136 + ks * 32 + 8 * fq;
                aY[d] = mfma16(*(const LAS bf16x8*)(XT + bo), ag, aY[d]); aF[d] = mfma16(*(const LAS bf16x8*)(PF + bo), ac, aF[d]); aB[d] = mfma16(*(const LAS bf16x8*)(PB + bo), ac, aB[d]); }
            asm volatile("" ::: "memory"); }
        const float ef = __expf(csl), eb = __expf(sbl);
#pragma unroll
        for (int d = 0; d < 4; ++d) { bf16_t* zp = ZQ + zrow + h * 64 + d * 16 + 4 * fq; const u32x2 zv = *(const u32x2*)zp;
            f32x4 y = aY[d] + aF[d] * ef + aB[d] * eb; const f32x4 z4 = {bflo(zv.x), bfhi(zv.x), bflo(zv.y), bfhi(zv.y)};
#pragma unroll
            for (int j = 0; j < 4; ++j) { y[j] *= silu_f(z4[j]); ss += y[j] * y[j]; }
            *(u32x2*)zp = pk4(y); }
    }
    ss += __shfl_xor(ss, 16); ss += __shfl_xor(ss, 32);
    const float rstd = rsqrtf(ss * (1.f / 512.f) + EPS); const float* nw = p.in[15] + g * 512;
#pragma unroll 2
    for (int h = 0; h < 8; ++h)
#pragma unroll
        for (int d = 0; d < 4; ++d) { const int pc = h * 64 + d * 16 + 4 * fq; bf16_t* zp = ZQ + zrow + pc; const u32x2 v = *(const u32x2*)zp; const f32x4 w4 = *(const f32x4*)(nw + pc);
            const f32x4 y = {bflo(v.x) * rstd * w4[0], bfhi(v.x) * rstd * w4[1], bflo(v.y) * rstd * w4[2], bfhi(v.y) * rstd * w4[3]};
            *(u32x2*)zp = pk4(y); }
}

__device__ __forceinline__ void attn_item(const Params& p, LAS unsigned char* lds, int seq, int qb, int kvh) {
    int tid = threadIdx.x; asm volatile("" : "+v"(tid));
    const int lane = tid & 63, wave = __builtin_amdgcn_readfirstlane(tid >> 6), fr = lane & 15, fq = lane >> 4;
    LAS bf16_t* Ks = (LAS bf16_t*)lds;
    LAS bf16_t* VT = Ks + 384 * 72;
    LAS bf16_t* Pw = VT + 64 * 392 + wave * (16 * 136);
    const bf16_t* KV = (const bf16_t*)(p.ws + WS_KV); bf16_t* ZQ = (bf16_t*)(p.ws + WS_ZQ);
    const int qs = qb * 128, rowbase = seq * SEQL;
    __syncthreads();
#pragma unroll
    for (int it = 0; it < 6; ++it) { const int idx = tid + 512 * it, j = idx >> 3, c = idx & 7, sp = qs - 128 + j; const bool ok = sp >= 0 && sp < SEQL;
        u32x4 v = *(const u32x4*)(KV + (size_t)(rowbase + (ok ? sp : qs)) * 512 + kvh * 64 + c * 8); if (!ok) v = (u32x4){0u, 0u, 0u, 0u};
        *(LAS u32x4*)(Ks + j * 72 + c * 8) = v; }
#pragma unroll
    for (int it = 0; it < 3; ++it) { const int j0 = 2 * (lane + 64 * it), sp = qs - 128 + j0; const bool ok = sp >= 0 && sp < SEQL;
        const bf16_t* src = KV + (size_t)(rowbase + (ok ? sp : qs)) * 512 + 256 + kvh * 64 + wave * 8;
        u32x4 v0 = *(const u32x4*)src, v1 = *(const u32x4*)(src + 512); if (!ok) { v0 = (u32x4){0u, 0u, 0u, 0u}; v1 = v0; }
        LAS bf16_t* dst = VT + (wave * 8) * 392 + j0;
        *(LAS unsigned*)(dst + 0 * 392) = (v0.x & 0xffffu) | (v1.x << 16); *(LAS unsigned*)(dst + 1 * 392) = (v0.x >> 16) | (v1.x & 0xffff0000u);
        *(LAS unsigned*)(dst + 2 * 392) = (v0.y & 0xffffu) | (v1.y << 16); *(LAS unsigned*)(dst + 3 * 392) = (v0.y >> 16) | (v1.y & 0xffff0000u);
        *(LAS unsigned*)(dst + 4 * 392) = (v0.z & 0xffffu) | (v1.z << 16); *(LAS unsigned*)(dst + 5 * 392) = (v0.z >> 16) | (v1.z & 0xffff0000u);
        *(LAS unsigned*)(dst + 6 * 392) = (v0.w & 0xffffu) | (v1.w << 16); *(LAS unsigned*)(dst + 7 * 392) = (v0.w >> 16) | (v1.w & 0xffff0000u); }
    const int hq = kvh * 4 + (wave >> 1), r0 = qs + 64 * (wave & 1);
    bf16_t* qbase = ZQ + (size_t)(rowbase + r0 + fr) * 2048 + 1024 + hq * 64;
    bf16x8 qf[4][2];
#pragma unroll
    for (int mt = 0; mt < 4; ++mt)
#pragma unroll
        for (int k = 0; k < 2; ++k) qf[mt][k] = *(const bf16x8*)(qbase + (size_t)mt * 16 * 2048 + k * 32 + 8 * fq);
    __syncthreads();
    const float slope2 = __builtin_amdgcn_exp2f(-0.5f * (float)(hq + 1)) * LOG2E, sink2 = p.in[16][hq] * LOG2E, sc2 = 0.125f * LOG2E;
#pragma unroll 1
    for (int mt = 0; mt < 4; ++mt) {
        const bf16x8 q0 = mt == 0 ? qf[0][0] : (mt == 1 ? qf[1][0] : (mt == 2 ? qf[2][0] : qf[3][0]));
        const bf16x8 q1 = mt == 0 ? qf[0][1] : (mt == 1 ? qf[1][1] : (mt == 2 ? qf[2][1] : qf[3][1]));
        f32x4 O[4]; float mrun = sink2, lrun = 1.f;
#pragma unroll
        for (int d = 0; d < 4; ++d) O[d] = (f32x4){0.f, 0.f, 0.f, 0.f};
        const int tq = r0 + mt * 16 + fr;
#pragma unroll 1
        for (int kb = 0; kb < 3; ++kb) {
            f32x4 s[8];
#pragma unroll
            for (int nt = 0; nt < 8; ++nt) { s[nt] = (f32x4){0.f, 0.f, 0.f, 0.f};
                s[nt] = mfma16(*(const LAS bf16x8*)(Ks + (kb * 128 + nt * 16 + fr) * 72 + 8 * fq), q0, s[nt]);
                s[nt] = mfma16(*(const LAS bf16x8*)(Ks + (kb * 128 + nt * 16 + fr) * 72 + 32 + 8 * fq), q1, s[nt]); }
            float tmax = -INFINITY;
#pragma unroll
            for (int nt = 0; nt < 8; ++nt)
#pragma unroll
                for (int r = 0; r < 4; ++r) { const int tk = qs - 128 + kb * 128 + nt * 16 + 4 * fq + r; const int dd = tq > tk ? tq - tk : tk - tq; const bool ok = dd <= 128 && tk >= 0 && tk < SEQL;
                    const float v = ok ? s[nt][r] * sc2 - slope2 * (float)dd : -INFINITY; s[nt][r] = v; tmax = fmaxf(tmax, v); }
            tmax = fmaxf(tmax, __shfl_xor(tmax, 16)); tmax = fmaxf(tmax, __shfl_xor(tmax, 32));
            const float mnew = fmaxf(mrun, tmax), alpha = __builtin_amdgcn_exp2f(mrun - mnew); float rsum = 0.f;
#pragma unroll
            for (int nt = 0; nt < 8; ++nt) {
#pragma unroll
                for (int r = 0; r < 4; ++r) { const float pv = __builtin_amdgcn_exp2f(s[nt][r] - mnew); s[nt][r] = pv; rsum += pv; }
                *(LAS u32x2*)(Pw + fr * 136 + nt * 16 + 4 * fq) = pk4(s[nt]); }
            asm volatile("" ::: "memory");
            rsum += __shfl_xor(rsum, 16); rsum += __shfl_xor(rsum, 32);
            lrun = lrun * alpha + rsum; mrun = mnew;
#pragma unroll
            for (int d = 0; d < 4; ++d) O[d] *= alpha;
#pragma unroll
            for (int k = 0; k < 4; ++k) { const bf16x8 pf = *(const LAS bf16x8*)(Pw + fr * 136 + k * 32 + 8 * fq);
#pragma unroll
                for (int d = 0; d < 4; ++d) O[d] = mfma16(*(const LAS bf16x8*)(VT + (d * 16 + fr) * 392 + kb * 128 + k * 32 + 8 * fq), pf, O[d]); }
            asm volatile("" ::: "memory");
        }
        const float inv = 1.f / lrun;
#pragma unroll
        for (int d = 0; d < 4; ++d) *(u32x2*)(qbase + (size_t)mt * 16 * 2048 + d * 16 + 4 * fq) = pk4(O[d] * inv);
    }
}

__device__ __forceinline__ void final_norm_phase(const Params& p, int gw, int ngw, int lane) {
    const float* rowss = (const float*)(p.ws + WS_SMALL) + (size_t)2 * T * 16; const float* nw = p.in[22];
    f32x4 wv[4];
#pragma unroll
    for (int j = 0; j < 4; ++j) wv[j] = *(const f32x4*)(nw + 4 * lane + 256 * j);
    for (int m = gw; m < T; m += ngw) { float* xr = p.out + (size_t)m * D + 4 * lane; const float rs = row_rs(rowss, m);
#pragma unroll
        for (int j = 0; j < 4; ++j) { const f32x4 v = *(const f32x4*)(xr + 256 * j); *(f32x4*)(xr + 256 * j) = v * rs * wv[j]; } }
}

constexpr int NPHASE = 10;
__global__ void __launch_bounds__(512, 2) hymba_fwd(Params p, int ph_lo, int ph_hi) {
    extern __shared__ __attribute__((aligned(16))) unsigned char lds_raw[];
    LAS unsigned char* lds = (LAS unsigned char*)lds_raw;
    const int tid = threadIdx.x, lane = tid & 63, wave = __builtin_amdgcn_readfirstlane(tid >> 6);
    const int G = gridDim.x, bx = blockIdx.x, gw = bx * 8 + wave, ngw = G * 8;
    unsigned char* ws = p.ws;
    float* rowss = (float*)(ws + WS_SMALL);
    bf16_t* XNB = (bf16_t*)(ws + WS_XNB); bf16_t* Hb = (bf16_t*)(ws + WS_H); bf16_t* X1B = (bf16_t*)p.out;
#if MK_LAUNCH_PER_PHASE
#define SEAM(k) do { } while (0)
#else
    cg::grid_group grid = cg::this_grid();
#define SEAM(k) do { if (ph_lo <= (k) && (k) + 1 < ph_hi) grid.sync(); } while (0)
#endif
#ifdef ONLY
#define IN(k) ((k) == ONLY && ph_lo <= (k) && (k) < ph_hi)
#else
#define IN(k) (ph_lo <= (k) && (k) < ph_hi)
#endif
    if (IN(0)) { phase0(p, lds, gw, ngw, lane, wave); }
    SEAM(0);
    if (IN(1)) { pg8::Gemm g{XNB, (const bf16_t*)(ws + WS_WFA), T, 2 * FF, D}; pg8::StaticOrder S; S.init(T, 2 * FF, G, bx); EpiGateUp E{Hb, nullptr};
        pg8::gemm_phase<EpiGateUp, pg8::StaticOrder, true, true>(lds, g, S, E); }
    SEAM(1);
    if (IN(2)) { pg8::Gemm g{Hb, (const bf16_t*)(ws + WS_WFD), T, D, FF}; pg8::StaticOrder S; S.init(T, D, G, bx); EpiDown1 E{p.in[0], p.in[1], XNB, X1B, rowss};
        pg8::gemm_phase<EpiDown1, pg8::StaticOrder, true, true>(lds, g, S, E); }
    SEAM(2);
    if (IN(3)) { pg8::Gemm g{X1B, (const bf16_t*)(ws + WS_WIN), T, 4096, D}; pg8::StaticOrder S; S.init(T, 4096, G, bx);
        EpiInProj E{(bf16_t*)(ws + WS_ZQ), (bf16_t*)(ws + WS_XBC), (bf16_t*)(ws + WS_KV), rowss};
        pg8::gemm_phase<EpiInProj, pg8::StaticOrder, true, true>(lds, g, S, E);
        dt_phase(p, X1B, gw, ngw, lane); }
    SEAM(3);
    if (IN(4)) {
        for (int it = bx; it < 768 + 1536; it += G) {
#if defined(DBG_P4) && DBG_P4 == 1
            if (it < 768) ssd_states_item(p, lds, it >> 1, it & 1);
#elif defined(DBG_P4) && DBG_P4 == 2
            if (it >= 768) { const int a = it - 768; attn_item(p, lds, a / 256, (a >> 2) & 63, a & 3); }
#else
            if (it < 768) ssd_states_item(p, lds, it >> 1, it & 1);
            else { const int a = it - 768; attn_item(p, lds, a / 256, (a >> 2) & 63, a & 3); }
#endif
        }
    }
    SEAM(4);
    if (IN(5)) { ssd_scan_phase(p); }
    SEAM(5);
    if (IN(6)) { for (int it = bx; it < 768; it += G) ssd_out_item(p, lds, it >> 1, it & 1); }
    SEAM(6);
    if (IN(7)) {
        __syncthreads();
        { LAS float* scr = (LAS float*)(lds + wave * 16384); for (int it = gw; it < FFN_W_ITEMS; it += ngw) ffn_weight_item(p.in[19], p.in[20], p.in[21], p.in[18], ws, scr, it, lane); }
        __syncthreads();
        pg8::Gemm g{(const bf16_t*)(ws + WS_ZQ), (const bf16_t*)(ws + WS_WOUT), T, D, 2048}; pg8::StaticOrder S; S.init(T, D, G, bx); EpiOutProj E{p.in[0], p.in[1], XNB, p.out, rowss + (size_t)T * 16};
        pg8::gemm_phase<EpiOutProj, pg8::StaticOrder, true, true>(lds, g, S, E); }
    SEAM(7);
    if (IN(8)) { pg8::Gemm g{XNB, (const bf16_t*)(ws + WS_WFA), T, 2 * FF, D}; pg8::StaticOrder S; S.init(T, 2 * FF, G, bx); EpiGateUp E{Hb, rowss + (size_t)T * 16};
        pg8::gemm_phase<EpiGateUp, pg8::StaticOrder, true, true>(lds, g, S, E); }
    SEAM(8);
    if (IN(9)) { pg8::Gemm g{Hb, (const bf16_t*)(ws + WS_WFD), T, D, FF}; pg8::StaticOrder S; S.init(T, D, G, bx); EpiDown2 E{p.out, rowss + (size_t)2 * T * 16};
        pg8::gemm_phase<EpiDown2, pg8::StaticOrder, true, true>(lds, g, S, E); }
    SEAM(9);
    if (IN(10)) { final_norm_phase(p, gw, ngw, lane); }
#undef IN
#undef SEAM
}


#ifdef DBG_STOP
__global__ void dbg_dump(Params p, int mode) {
    const bf16_t* ZQ = (const bf16_t*)(p.ws + WS_ZQ); const bf16_t* XBC = (const bf16_t*)(p.ws + WS_XBC); const bf16_t* KV = (const bf16_t*)(p.ws + WS_KV); const float* DT = (const float*)(p.ws + WS_DT);
    const bf16_t* Hb = (const bf16_t*)(p.ws + WS_H); const bf16_t* XNB = (const bf16_t*)(p.ws + WS_XNB);
    for (size_t i = (size_t)blockIdx.x * blockDim.x + threadIdx.x; i < (size_t)T * D; i += (size_t)gridDim.x * blockDim.x) {
        float v = 0.f;
        if (mode == 1) { v = bflo(Hb[i]) + bflo(Hb[i + (size_t)T * D]) + bflo(Hb[(i + (size_t)2 * T * D) % ((size_t)T * FF)]); }
        else if (mode == 2) { v = bflo(XNB[i]); }
        else if (mode == 3 || mode == 4 || mode == 6) { v = bflo(ZQ[2 * i]) + bflo(ZQ[2 * i + 1]) + bflo(XBC[i]) + bflo(XBC[i + (size_t)T * 512]) + bflo(KV[i % ((size_t)T * 512)]) + DT[i % ((size_t)T * 32)]; }
        if (mode == 2 || mode == 4 || mode == 5) { const unsigned w = ((const unsigned*)p.out)[i]; v += bflo(w) + bfhi(w); }
        if (!(fabsf(v) < 1e30f)) v = 777.f;
        p.out[i] = v;
    }
}
#endif
extern "C" void kernel_launch(void* const* d_in, const int* in_sizes, int n_in, void* d_out, int out_size, void* d_ws, size_t ws_size, hipStream_t stream) {
    static int grid = 0;
    if (grid == 0) {
        if (n_in != 23 || out_size != T * D || ws_size < WS_END) { fprintf(stderr, "kernel_launch: unexpected shapes: n_in %d out %d ws %zu (need %zu)\n", n_in, out_size, ws_size, (size_t)WS_END); grid = -1; return; }
        int dev = 0, cus = 0, per_cu = 0;
        hipGetDevice(&dev); hipDeviceGetAttribute(&cus, hipDeviceAttributeMultiprocessorCount, dev);
        if (hipFuncSetAttribute((const void*)hymba_fwd, hipFuncAttributeMaxDynamicSharedMemorySize, LDS_BYTES) != hipSuccess) { fprintf(stderr, "kernel_launch: hipFuncSetAttribute failed\n"); grid = -1; return; }
        if (hipOccupancyMaxActiveBlocksPerMultiprocessor(&per_cu, (const void*)hymba_fwd, 512, LDS_BYTES) != hipSuccess || per_cu < 1) { fprintf(stderr, "kernel_launch: occupancy query says %d\n", per_cu); per_cu = 1; }
        (void)hipGetLastError();
        grid = cus;
    }
    if (grid < 0) return;
    Params p{};
    for (int i = 0; i < 23; ++i) p.in[i] = (const float*)d_in[i];
    p.out = (float*)d_out; p.ws = (unsigned char*)d_ws;
#if MK_LAUNCH_PER_PHASE
#ifdef DBG_STOP
    for (int k = 0; k <= DBG_STOP; ++k) hipLaunchKernelGGL(hymba_fwd, dim3(grid), dim3(512), LDS_BYTES, stream, p, k, k + 1);
    hipLaunchKernelGGL(dbg_dump, dim3(2048), dim3(256), 0, stream, p, DBG_STOP);
#else
    for (int k = 0; k <= NPHASE; ++k) hipLaunchKernelGGL(hymba_fwd, dim3(grid), dim3(512), LDS_BYTES, stream, p, k, k + 1);
#endif
#else
    int lo = 0, hi = NPHASE + 1;
    void* args[] = {&p, &lo, &hi};
    hipError_t e = hipLaunchCooperativeKernel((const void*)hymba_fwd, dim3(grid), dim3(512), args, LDS_BYTES, stream);
    if (e != hipSuccess) fprintf(stderr, "kernel_launch: cooperative launch failed: %s (grid %d)\n", hipGetErrorString(e), grid);
#endif
}
```

```cpp
#include <hip/hip_runtime.h>
#include <hip/hip_cooperative_groups.h>
#include <cstdio>
#include <cstdint>
namespace cg = cooperative_groups;
namespace pg8 {
#define PG8_LAS __attribute__((address_space(3)))
typedef unsigned short bf16_t;
typedef short bf16x8 __attribute__((ext_vector_type(8)));
typedef float f32x4 __attribute__((ext_vector_type(4)));
typedef unsigned u32x4 __attribute__((ext_vector_type(4)));
constexpr int BM = 256, BK = 64, HALF = 128, HTB = HALF * BK * 2  , STAGE_BYTES = 8 * HTB, NXCD = 8, WGM = 8;

__host__ __device__ __forceinline__ int lds_byte(int r, int c) { const int st = (r >> 4) * 2 + (c >> 5), rr = r & 15, cc = c & 31, ob = rr * 64 + cc * 2; return st * 1024 + (ob ^ (((ob >> 9) & 1) << 5)); }
__host__ __device__ __forceinline__ void stage_rc(int b, int& R, int& C) { const int st = b / 1024, sb = b % 1024, swz = sb ^ (((sb >> 9) & 1) << 5); R = (st >> 1) * 16 + swz / 64; C = (st & 1) * 32 + (swz % 64) / 2; }
__host__ __device__ __forceinline__ int perm32(int rho) { const int n = rho >> 4, i = rho & 15; return 8 * (i >> 2) + 4 * n + (i & 3); }

struct Unit { int pm, pn; };
struct Gemm { const bf16_t* A; const bf16_t* Bt; int M, N, K; };

struct StaticOrder {
    int nM, nN, nwg, G, c;
    __host__ __device__ void init(int M, int N, int G_, int c_) { nM = M / BM; nN = N / BM; nwg = nM * nN; G = G_; c = c_; }
    __host__ __device__ bool next(int i, Unit& u) const {
        const long L = (long)i * G + c; if (L >= nwg) return false;
        int wgid = (int)L; { const int q = nwg / NXCD, r = nwg % NXCD, xcd = wgid % NXCD, off = wgid / NXCD; wgid = (xcd < r ? xcd * (q + 1) : r * (q + 1) + (xcd - r) * q) + off; }
        const int nig = WGM * nN, gid = wgid / nig, fm = gid * WGM, gsz = (nM - fm) < WGM ? (nM - fm) : WGM;
        u.pm = fm + ((wgid % nig) % gsz); u.pn = (wgid % nig) / gsz; return true;
    }
    __device__ __forceinline__ void a_ready(const Unit&) const {}
    __device__ __forceinline__ void done(const Unit&) const {}
};

__device__ __forceinline__ unsigned cvt_pk_bf16(float lo, float hi) { unsigned r; asm volatile("v_cvt_pk_bf16_f32 %0, %1, %2" : "=v"(r) : "v"(lo), "v"(hi)); return r; }
template <class Epi, class Sched, bool ALIGN_EPI = false, bool SP2 = false>
__device__ __forceinline__ void gemm_phase(PG8_LAS unsigned char* lds, const Gemm g, const Sched& S, const Epi& E) {
    const int tid = threadIdx.x, wid = __builtin_amdgcn_readfirstlane(tid >> 6), lane = tid & 63, wr = wid >> 2, wc = wid & 3, fr = lane & 15, fq = lane >> 4;
    const int K = g.K, nt = K / BK;
    unsigned voffA[2], voffB[2];
#pragma unroll
    for (int i = 0; i < 2; ++i) { int R, C; stage_rc(tid * 16 + i * 8192, R, C); const int Rb = Epi::PERM ? ((R & ~31) + perm32(R & 31)) : R;
        voffA[i] = (unsigned)(R * K + C) * 2u; voffB[i] = (unsigned)(Rb * K + C) * 2u; }
    const size_t kstep = (size_t)(BK * 2);
    const size_t hstep = (size_t)HALF * K * 2;
    const size_t tstep = 2 * hstep;
    const unsigned ldsw = (unsigned)wid * 1024u;
    const int aoff = lds_byte(wr * 64 + fr, fq * 8), boff = lds_byte(wc * 32 + fr, fq * 8);
#define PG8_SA(b, h) (((b) * 2 + (h)) * HTB)
#define PG8_SB(b, h) ((4 + (b) * 2 + (h)) * HTB)
#define PG8_STAGE(bufoff, gbase, voff) do { _Pragma("unroll") for (int _i = 0; _i < 2; ++_i) \
        __builtin_amdgcn_global_load_lds((const unsigned*)((const char*)(gbase) + (voff)[_i]), (PG8_LAS unsigned*)(lds + (bufoff) + ldsw + _i * 8192), 16, 0, 0); } while (0)
#define PG8_LDA(dst, b, h) do { _Pragma("unroll") for (int m = 0; m < 4; ++m) _Pragma("unroll") for (int k = 0; k < 2; ++k) dst[m][k] = *(const PG8_LAS bf16x8*)(lds + PG8_SA(b, h) + aoff + m * 2048 + k * 1024); } while (0)
#define PG8_LDB(dst, b, h) do { _Pragma("unroll") for (int n = 0; n < 2; ++n) _Pragma("unroll") for (int k = 0; k < 2; ++k) dst[n][k] = *(const PG8_LAS bf16x8*)(lds + PG8_SB(b, h) + boff + n * 2048 + k * 1024); } while (0)
#define PG8_MMA(ai, bj, At, Bt) do { __builtin_amdgcn_s_setprio(1); _Pragma("unroll") for (int m = 0; m < 4; ++m) _Pragma("unroll") for (int n = 0; n < 2; ++n) _Pragma("unroll") for (int k = 0; k < 2; ++k) \
        acc[ai][bj][m][n] = __builtin_amdgcn_mfma_f32_16x16x32_bf16(Bt[n][k], At[m][k], acc[ai][bj][m][n], 0, 0, 0); __builtin_amdgcn_s_setprio(0); } while (0)
#define PG8_WAIT_V(n) asm volatile("s_waitcnt vmcnt(" #n ")" ::: "memory")
#define PG8_WAIT_L(n) asm volatile("s_waitcnt lgkmcnt(" #n ")" ::: "memory")
#define PG8_BAR __builtin_amdgcn_s_barrier()
#define PG8_SCHED __builtin_amdgcn_sched_barrier(0)
    Unit cur, nxt; int ui = 0;
    if (!S.next(0, cur)) return;
    f32x4 acc[2][2][4][2];
#pragma unroll
    for (int a = 0; a < 2; ++a)
#pragma unroll
        for (int b = 0; b < 2; ++b)
#pragma unroll
            for (int m = 0; m < 4; ++m)
#pragma unroll
                for (int n = 0; n < 2; ++n) acc[a][b][m][n] = (f32x4){0.f, 0.f, 0.f, 0.f};
    bf16x8 At[4][2], B0[2][2], B1[2][2];
    const char* cA = (const char*)g.A + (size_t)cur.pm * tstep; const char* cB = (const char*)g.Bt + (size_t)cur.pn * tstep;
    S.a_ready(cur);
    if constexpr (SP2) {
        PG8_STAGE(PG8_SB(0, 0), cB, voffB); PG8_STAGE(PG8_SB(0, 1), cB + hstep, voffB); PG8_STAGE(PG8_SA(0, 0), cA, voffA); PG8_STAGE(PG8_SA(0, 1), cA + hstep, voffA);
        if (wr == 1) PG8_BAR;
        PG8_WAIT_V(2); PG8_BAR;
        PG8_STAGE(PG8_SB(1, 0), cB + kstep, voffB); PG8_STAGE(PG8_SA(1, 0), cA + kstep, voffA); PG8_STAGE(PG8_SB(1, 1), cB + hstep + kstep, voffB);
        PG8_WAIT_V(6); PG8_BAR;
    } else {
        PG8_STAGE(PG8_SB(0, 0), cB, voffB); PG8_STAGE(PG8_SA(0, 0), cA, voffA); PG8_STAGE(PG8_SB(0, 1), cB + hstep, voffB); PG8_STAGE(PG8_SA(0, 1), cA + hstep, voffA);
        if (wr == 1) PG8_BAR;
        PG8_WAIT_V(4); PG8_BAR;
        PG8_STAGE(PG8_SB(1, 0), cB + kstep, voffB); PG8_STAGE(PG8_SA(1, 0), cA + kstep, voffA); PG8_STAGE(PG8_SB(1, 1), cB + hstep + kstep, voffB);
        PG8_WAIT_V(6); PG8_BAR;
    }
    for (;;) {
        const bool has_next = S.next(ui + 1, nxt);
        const char* nA = has_next ? (const char*)g.A + (size_t)nxt.pm * tstep : cA; const char* nB = has_next ? (const char*)g.Bt + (size_t)nxt.pn * tstep : cB;
        for (int t = 0; t < nt; t += 2) {
            const bool last = (t == nt - 2);
            const char* a1 = cA + (size_t)(t + 1) * kstep;
            const char* a2 = last ? nA : cA + (size_t)(t + 2) * kstep; const char* b2 = last ? nB : cB + (size_t)(t + 2) * kstep;
            const char* a3 = a2 + kstep; const char* b3 = b2 + kstep;
            if (last && has_next) S.a_ready(nxt);
            if constexpr (SP2) {
            PG8_LDB(B0, 0, 0); PG8_LDB(B1, 0, 1); PG8_SCHED; PG8_LDA(At, 0, 0); PG8_STAGE(PG8_SA(1, 1), a1 + hstep, voffA);
            PG8_WAIT_V(8); PG8_WAIT_L(0); PG8_BAR; PG8_MMA(0, 0, At, B0); PG8_MMA(0, 1, At, B1); PG8_BAR; PG8_SCHED;
            PG8_LDA(At, 0, 1); PG8_STAGE(PG8_SB(0, 0), b2, voffB); PG8_STAGE(PG8_SB(0, 1), b2 + hstep, voffB); PG8_STAGE(PG8_SA(0, 0), a2, voffA);
            PG8_WAIT_V(8); PG8_WAIT_L(0); PG8_BAR; PG8_MMA(1, 0, At, B0); PG8_MMA(1, 1, At, B1); PG8_BAR; PG8_SCHED;
            PG8_LDB(B0, 1, 0); PG8_LDB(B1, 1, 1); PG8_SCHED; PG8_LDA(At, 1, 0); PG8_STAGE(PG8_SA(0, 1), a2 + hstep, voffA);
            PG8_WAIT_V(8); PG8_WAIT_L(0); PG8_BAR; PG8_MMA(0, 0, At, B0); PG8_MMA(0, 1, At, B1); PG8_BAR; PG8_SCHED;
            PG8_LDA(At, 1, 1); PG8_STAGE(PG8_SB(1, 0), b3, voffB); PG8_STAGE(PG8_SB(1, 1), b3 + hstep, voffB); PG8_STAGE(PG8_SA(1, 0), a3, voffA);
            PG8_WAIT_V(8); PG8_WAIT_L(0); PG8_BAR; PG8_MMA(1, 0, At, B0); PG8_MMA(1, 1, At, B1); PG8_BAR; PG8_SCHED;
            } else {
            PG8_LDB(B0, 0, 0); PG8_SCHED; PG8_LDA(At, 0, 0); PG8_STAGE(PG8_SA(1, 1), a1 + hstep, voffA);
            PG8_WAIT_L(8); PG8_BAR; PG8_WAIT_L(0); PG8_MMA(0, 0, At, B0); PG8_BAR; PG8_SCHED;
            PG8_LDB(B1, 0, 1); PG8_STAGE(PG8_SB(0, 0), b2, voffB);
            PG8_BAR; PG8_WAIT_L(0); PG8_MMA(0, 1, At, B1); PG8_BAR;
            PG8_LDA(At, 0, 1); PG8_STAGE(PG8_SA(0, 0), a2, voffA);
            PG8_BAR; PG8_WAIT_L(0); PG8_MMA(1, 0, At, B0); PG8_BAR; PG8_SCHED;
            PG8_STAGE(PG8_SB(0, 1), b2 + hstep, voffB);
            PG8_WAIT_V(6); PG8_BAR; PG8_MMA(1, 1, At, B1); PG8_BAR;
            PG8_LDB(B0, 1, 0); PG8_SCHED; PG8_LDA(At, 1, 0); PG8_STAGE(PG8_SA(0, 1), a2 + hstep, voffA);
            PG8_WAIT_L(8); PG8_BAR; PG8_WAIT_L(0); PG8_MMA(0, 0, At, B0); PG8_BAR; PG8_SCHED;
            PG8_LDB(B1, 1, 1); PG8_STAGE(PG8_SB(1, 0), b3, voffB);
            PG8_BAR; PG8_WAIT_L(0); PG8_MMA(0, 1, At, B1); PG8_BAR;
            PG8_LDA(At, 1, 1); PG8_STAGE(PG8_SA(1, 0), a3, voffA);
            PG8_BAR; PG8_WAIT_L(0); PG8_MMA(1, 0, At, B0); PG8_BAR; PG8_SCHED;
            PG8_STAGE(PG8_SB(1, 1), b3 + hstep, voffB);
            PG8_WAIT_V(6); PG8_BAR; PG8_MMA(1, 1, At, B1); PG8_BAR;
            }
        }
        if constexpr (ALIGN_EPI) { if (wr == 0) PG8_BAR; }
        if constexpr (!Epi::AFTER_DRAIN) { E(acc, cur, wr, wc, fr, fq); S.done(cur); }
        if (!has_next) break;
#pragma unroll
        for (int a = 0; a < 2; ++a)
#pragma unroll
            for (int b = 0; b < 2; ++b)
#pragma unroll
                for (int m = 0; m < 4; ++m)
#pragma unroll
                    for (int n = 0; n < 2; ++n) acc[a][b][m][n] = (f32x4){0.f, 0.f, 0.f, 0.f};
        cur = nxt; cA = nA; cB = nB; ++ui;
        if constexpr (ALIGN_EPI) { if (wr == 1) PG8_BAR; }
    }
    PG8_WAIT_V(0);
    if constexpr (!ALIGN_EPI) { if (wr == 0) PG8_BAR; }
    PG8_BAR;
    if constexpr (Epi::AFTER_DRAIN) { E.fused(acc, cur, wr, wc, fr, fq, lds, wid, lane); S.done(cur); }
#undef PG8_SA
#undef PG8_SB
#undef PG8_STAGE
#undef PG8_LDA
#undef PG8_LDB
#undef PG8_MMA
#undef PG8_WAIT_V
#undef PG8_WAIT_L
#undef PG8_BAR
#undef PG8_SCHED
}
}

using pg8::bf16_t; using pg8::bf16x8; using pg8::f32x4; using pg8::u32x4;
typedef __bf16 bf16v2_t __attribute__((ext_vector_type(2)));
typedef float f32v2_t __attribute__((ext_vector_type(2)));
__device__ __forceinline__ unsigned cvt_pk_bf16(float lo, float hi) { const f32v2_t v = {lo, hi}; const bf16v2_t b = __builtin_convertvector(v, bf16v2_t); return __builtin_bit_cast(unsigned, b); }
#define LAS __attribute__((address_space(3)))
typedef unsigned u32x2 __attribute__((ext_vector_type(2)));

#ifndef MK_LAUNCH_PER_PHASE
#define MK_LAUNCH_PER_PHASE 0
#endif

constexpr int T = 49152, D = 1024, FF = 2816, SEQL = 8192, TP = 32768, NCHUNK = 384;
constexpr float EPS = 1e-6f;
constexpr float LOG2E = 1.44269504088896f;
constexpr size_t MiB = 1u << 20;
constexpr size_t WS_ZQ = 0;
constexpr size_t WS_XBC = 192 * MiB;
constexpr size_t WS_KV = 336 * MiB;
constexpr size_t WS_DT = 384 * MiB;
constexpr size_t WS_XNB = 390 * MiB;
constexpr size_t WS_WIN = 486 * MiB;
constexpr size_t WS_WOUT = 495 * MiB;
constexpr size_t WS_SMALL = 499 * MiB;
constexpr size_t WS_HALO = 505 * MiB;
constexpr size_t WS_CHDEC = 509 * MiB;
constexpr size_t WS_BAR = 510 * MiB;
constexpr size_t WS_W2A = 512 * MiB;
constexpr size_t WS_W2D = 523 * MiB;
constexpr size_t WS_END = 529 * MiB;
constexpr size_t WS_H = 0;
constexpr size_t WS_WFA = 264 * MiB;
constexpr size_t WS_WFD = 275 * MiB;
constexpr int LDS_BYTES = 147456;

#define XB_TMO      128
#define XB_XCNT(j)  (256  + 64 * (j))
#define XB_XSUB(j)  (1280 + 64 * (j))
#define XB_XGEN(j)  (2304 + 64 * (j))
#define XB_TOP      3328
#define XB_TOPGEN   3392
#define XCD_BAR_WORDS 3456
#define XB_SPIN_CAP (1u << 18)

__device__ __forceinline__ unsigned xb_ld(unsigned* p)              { return __hip_atomic_load(p, __ATOMIC_RELAXED, __HIP_MEMORY_SCOPE_AGENT); }
__device__ __forceinline__ unsigned xb_add(unsigned* p, unsigned v) { return __hip_atomic_fetch_add(p, v, __ATOMIC_RELAXED, __HIP_MEMORY_SCOPE_AGENT); }
__device__ __forceinline__ unsigned xb_xcc_id() { return (unsigned)__builtin_amdgcn_s_getreg((3 << 11) | 20) & 0xFu; }
#define XB_SPIN(cond, bar) do { unsigned _sp = 0; while (cond) { __builtin_amdgcn_s_sleep(1); \
    if ((++_sp & 255u) == 0u) { if (xb_ld(&(bar)[XB_TMO])) break; if (_sp > XB_SPIN_CAP) { atomicAdd(&(bar)[XB_TMO], 1u); break; } } } } while (0)

struct XcdBarrier {
    unsigned* bar; unsigned x;
    volatile LAS unsigned* st;
};

__device__ __forceinline__ XcdBarrier xcd_barrier_post(unsigned* bar, volatile LAS unsigned* st) {
    XcdBarrier b; b.bar = bar; b.x = xb_xcc_id(); b.st = st;
    if (threadIdx.x == 0) (void)xb_add(&bar[XB_XCNT(b.x)], 1u);
    return b;
}
__device__ __forceinline__ void xcd_barrier_complete(unsigned* bar, unsigned x, unsigned& nloc, unsigned& nx) {
    const unsigned G = gridDim.x * gridDim.y * gridDim.z;
    unsigned sum, cnt, mine, sp = 0u;
    for (;;) {
        sum = 0u; cnt = 0u; mine = 0u;
#pragma unroll
        for (unsigned j = 0; j < 16; ++j) { const unsigned c = xb_ld(&bar[XB_XCNT(j)]); sum += c; cnt += (c > 0u) ? 1u : 0u; mine = (j == x) ? c : mine; }
        if (sum == G) break;
        __builtin_amdgcn_s_sleep(1);
        if ((++sp & 255u) == 0u) { if (xb_ld(&bar[XB_TMO])) break; if (sp > XB_SPIN_CAP) { atomicAdd(&bar[XB_TMO], 1u); break; } }
    }
    nloc = mine > 0u ? mine : 1u; nx = cnt > 0u ? cnt : 1u;
}

__device__ __forceinline__ void xcd_barrier(const XcdBarrier& b) {
    asm volatile("s_waitcnt vmcnt(0)" ::: "memory");
    __syncthreads();
    if (threadIdx.x == 0) {
        unsigned* bar = b.bar;
        __builtin_amdgcn_s_waitcnt(0);
        unsigned nloc = b.st[0], nx = b.st[1];
        if (nloc == 0u) { xcd_barrier_complete(bar, b.x, nloc, nx); b.st[0] = nloc; b.st[1] = nx; }
        const unsigned old = xb_add(&bar[XB_XSUB(b.x)], 1u);
        const unsigned gen = old / nloc;
        if (old + 1u == (gen + 1u) * nloc) {
            __builtin_amdgcn_fence(__ATOMIC_RELEASE, "agent");
            asm volatile("s_waitcnt vmcnt(0)" ::: "memory");
            const unsigned og = xb_add(&bar[XB_TOP], 1u);
            const unsigned tg = og / nx;
            if (og + 1u == (tg + 1u) * nx) xb_add(&bar[XB_TOPGEN], 1u);
            else XB_SPIN(xb_ld(&bar[XB_TOPGEN]) == tg, bar);
            __builtin_amdgcn_fence(__ATOMIC_ACQUIRE, "agent");
            xb_add(&bar[XB_XGEN(b.x)], 1u);
            asm volatile("s_waitcnt vmcnt(0)" ::: "memory");
        } else {
            XB_SPIN(xb_ld(&bar[XB_XGEN(b.x)]) == gen, bar);
            __builtin_amdgcn_fence(__ATOMIC_ACQUIRE, "agent");
            asm volatile("s_waitcnt vmcnt(0)" ::: "memory");
        }
    }
    __syncthreads();
}

struct Params { const float* in[23]; float* out; unsigned char* ws; };
#ifdef TSA
#define ISTAMP(cond, k) do { if ((cond) && blockIdx.x == 0 && threadIdx.x == 0) ((unsigned long long*)(p.ws + WS_CHDEC + 65536))[k] = __builtin_amdgcn_s_memrealtime(); } while (0)
#else
#define ISTAMP(cond, k) do { } while (0)
#endif
#ifndef TSSCALE
#define TSSCALE 0.02f
#endif

__device__ __forceinline__ float bflo(unsigned w) { return __uint_as_float(w << 16); }
__device__ __forceinline__ float bfhi(unsigned w) { return __uint_as_float(w & 0xffff0000u); }
__device__ __forceinline__ float silu_f(float v) { return v * __builtin_amdgcn_rcpf(1.f + __expf(-v)); }
__device__ __forceinline__ float wave_sum(float v) {
#pragma unroll
    for (int o = 1; o < 64; o <<= 1) v += __shfl_xor(v, o);
    return v;
}
__device__ __forceinline__ float row_rs(const float* part, int row) {
    const f32x4* q = (const f32x4*)(part + (size_t)row * 16); const f32x4 a = q[0], b = q[1], c = q[2], d = q[3];
    const float s = (((a[0] + a[1]) + (a[2] + a[3])) + ((b[0] + b[1]) + (b[2] + b[3]))) + (((c[0] + c[1]) + (c[2] + c[3])) + ((d[0] + d[1]) + (d[2] + d[3])));
    return rsqrtf(s * (1.f / D) + EPS);
}
__device__ __forceinline__ float row_rs_q(const float* part, int row, int fq) {
    const f32x4 a = ((const f32x4*)(part + (size_t)row * 16))[fq]; float s = (a[0] + a[1]) + (a[2] + a[3]);
    s += __shfl_xor(s, 16); s += __shfl_xor(s, 32);
    return rsqrtf(s * (1.f / D) + EPS);
}
__device__ __forceinline__ u32x4 pk8(const f32x4 a, const f32x4 b) { u32x4 w; w.x = cvt_pk_bf16(a[0], a[1]); w.y = cvt_pk_bf16(a[2], a[3]); w.z = cvt_pk_bf16(b[0], b[1]); w.w = cvt_pk_bf16(b[2], b[3]); return w; }
__device__ __forceinline__ u32x2 pk4(const f32x4 a) { u32x2 w; w.x = cvt_pk_bf16(a[0], a[1]); w.y = cvt_pk_bf16(a[2], a[3]); return w; }
__device__ __forceinline__ f32x4 mfma16(const bf16x8 a, const bf16x8 b, const f32x4 c) { return __builtin_amdgcn_mfma_f32_16x16x32_bf16(a, b, c, 0, 0, 0); }

struct RsTab { const LAS float* tab; int g0; int ok; };
__device__ __forceinline__ float rs_lookup(const RsTab& t, const float* rowss, int pm, int row, int fq) { return t.ok ? t.tab[((pm >> 3) - t.g0) * 256 + (row & 255)] : row_rs_q(rowss, row, fq); }
template <bool HAS_RS> struct EpiGateUp {
    static constexpr bool PERM = true, AFTER_DRAIN = false;
    bf16_t* H; const float* rowss; RsTab rt;
    __device__ __forceinline__ void operator()(const f32x4 (&acc)[2][2][4][2], const pg8::Unit& u, int wr, int wc, int fr, int fq) const {
        const int row0 = u.pm * 256 + wr * 64 + fr, col0 = u.pn * 128 + wc * 32 + 8 * fq;
#pragma unroll
        for (int ai = 0; ai < 2; ++ai)
#pragma unroll
            for (int m = 0; m < 4; ++m) {
                const int row = row0 + ai * 128 + m * 16;
                f32x4 h0, h1;
                if constexpr (HAS_RS) { const float rs = rs_lookup(rt, rowss, u.pm, row, fq);
#pragma unroll
                    for (int j = 0; j < 4; ++j) { h0[j] = silu_f(acc[ai][0][m][0][j] * rs) * (acc[ai][1][m][0][j] * rs); h1[j] = silu_f(acc[ai][0][m][1][j] * rs) * (acc[ai][1][m][1][j] * rs); } }
                else {
#pragma unroll
                    for (int j = 0; j < 4; ++j) { h0[j] = silu_f(acc[ai][0][m][0][j]) * acc[ai][1][m][0][j]; h1[j] = silu_f(acc[ai][0][m][1][j]) * acc[ai][1][m][1][j]; } }
                *(u32x4*)(H + (size_t)row * FF + col0) = pk8(h0, h1);
            }
    }
};
struct EpiDown1 {
    static constexpr bool PERM = true, AFTER_DRAIN = false;
    const float* xp; const float* xs; bf16_t* x1b; float* rowss;
    __device__ __forceinline__ void operator()(const f32x4 (&acc)[2][2][4][2], const pg8::Unit& u, int wr, int wc, int fr, int fq) const {
        const int row0 = u.pm * 256 + wr * 64 + fr, col0 = u.pn * 256 + wc * 32 + 8 * fq;
#pragma unroll
        for (int ai = 0; ai < 2; ++ai)
#pragma unroll
            for (int mp = 0; mp < 2; ++mp) {
                f32x4 xv[2][2][2];
#pragma unroll
                for (int mm = 0; mm < 2; ++mm) { const int row = row0 + ai * 128 + (2 * mp + mm) * 16;
                    const float* xr = (row < TP ? xp + (size_t)row * D : xs + (size_t)(row - TP) * D) + col0;
#pragma unroll
                    for (int bj = 0; bj < 2; ++bj) { xv[mm][bj][0] = __builtin_nontemporal_load((const f32x4*)(xr + bj * 128)); xv[mm][bj][1] = __builtin_nontemporal_load((const f32x4*)(xr + bj * 128 + 4)); } }
#pragma unroll
                for (int mm = 0; mm < 2; ++mm) { const int m = 2 * mp + mm, row = row0 + ai * 128 + m * 16; const size_t o = (size_t)row * D + col0; float ss = 0.f;
#pragma unroll
                    for (int bj = 0; bj < 2; ++bj) {
                        const f32x4 d0 = acc[ai][bj][m][0] * 0.5f, d1 = acc[ai][bj][m][1] * 0.5f, y0 = xv[mm][bj][0] + d0, y1 = xv[mm][bj][1] + d1;
#pragma unroll
                        for (int j = 0; j < 4; ++j) ss += y0[j] * y0[j] + y1[j] * y1[j];
                        *(u32x4*)(x1b + o + bj * 128) = pk8(y0, y1); }
                    ss += __shfl_xor(ss, 16); ss += __shfl_xor(ss, 32);
                    if (fq == 0) rowss[(size_t)row * 16 + u.pn * 4 + wc] = ss; }
            }
    }
};
struct EpiInProj {
    static constexpr bool PERM = true, AFTER_DRAIN = false;
    bf16_t* zq; bf16_t* xbc; bf16_t* kv; const float* rowss; RsTab rt; bf16_t* halo;
    __device__ __forceinline__ void operator()(const f32x4 (&acc)[2][2][4][2], const pg8::Unit& u, int wr, int wc, int fr, int fq) const {
        const int row0 = u.pm * 256 + wr * 64 + fr, pn = u.pn;
        bf16_t* base; int pitch, cb;
        if (pn < 4) { base = zq; pitch = 2048; cb = pn * 256; } else if (pn < 10) { base = xbc; pitch = 1536; cb = (pn - 4) * 256; }
        else if (pn < 14) { base = zq; pitch = 2048; cb = 1024 + (pn - 10) * 256; } else { base = kv; pitch = 512; cb = (pn - 14) * 256; }
        const int col0 = cb + wc * 32 + 8 * fq;
#pragma unroll
        for (int ai = 0; ai < 2; ++ai)
#pragma unroll
            for (int m = 0; m < 4; ++m) {
                const int row = row0 + ai * 128 + m * 16;
                const float rs = rs_lookup(rt, rowss, u.pm, row, fq);
#pragma unroll
                for (int bj = 0; bj < 2; ++bj) { const u32x4 w = pk8(acc[ai][bj][m][0] * rs, acc[ai][bj][m][1] * rs);
                    *(u32x4*)(base + (size_t)row * pitch + col0 + bj * 128) = w;
                    if (pn >= 4 && pn < 8) { const int rl = row & 127; if (rl < 2 || rl >= 126) *(u32x4*)(halo + ((size_t)(row >> 7) * 4 + (rl < 2 ? rl : rl - 124)) * 1024 + col0 + bj * 128) = w; } }
            }
    }
};
struct EpiOutProj {
    static constexpr bool PERM = true, AFTER_DRAIN = false;
    bf16_t* dx; float* rowss;
    __device__ __forceinline__ void operator()(const f32x4 (&acc)[2][2][4][2], const pg8::Unit& u, int wr, int wc, int fr, int fq) const {
        const int row0 = u.pm * 256 + wr * 64 + fr, col0 = u.pn * 256 + wc * 32 + 8 * fq;
#pragma unroll
        for (int ai = 0; ai < 2; ++ai)
#pragma unroll
            for (int mp = 0; mp < 2; ++mp) {
                u32x4 dv[2][2];
#pragma unroll
                for (int mm = 0; mm < 2; ++mm) { const size_t o = (size_t)(row0 + ai * 128 + (2 * mp + mm) * 16) * D + col0;
#pragma unroll
                    for (int bj = 0; bj < 2; ++bj) dv[mm][bj] = *(const u32x4*)(dx + o + bj * 128); }
#pragma unroll
                for (int mm = 0; mm < 2; ++mm) { const int m = 2 * mp + mm, row = row0 + ai * 128 + m * 16; const size_t o = (size_t)row * D + col0; float ss = 0.f;
#pragma unroll
                    for (int bj = 0; bj < 2; ++bj) { const u32x4 dd = dv[mm][bj];
                        const f32x4 da = {bflo(dd.x), bfhi(dd.x), bflo(dd.y), bfhi(dd.y)}, db = {bflo(dd.z), bfhi(dd.z), bflo(dd.w), bfhi(dd.w)};
                        const f32x4 y0 = da + acc[ai][bj][m][0], y1 = db + acc[ai][bj][m][1];
#pragma unroll
                        for (int j = 0; j < 4; ++j) ss += y0[j] * y0[j] + y1[j] * y1[j];
                        *(u32x4*)(dx + o + bj * 128) = pk8(y0, y1); }
                    ss += __shfl_xor(ss, 16); ss += __shfl_xor(ss, 32);
                    if (fq == 0) rowss[(size_t)row * 16 + u.pn * 4 + wc] = ss; }
            }
    }
};
struct EpiDown2 {
    static constexpr bool PERM = true, AFTER_DRAIN = false;
    const float* out; bf16_t* x3b; float* rowss;
    __device__ __forceinline__ void operator()(const f32x4 (&acc)[2][2][4][2], const pg8::Unit& u, int wr, int wc, int fr, int fq) const {
        const int row0 = u.pm * 256 + wr * 64 + fr, col0 = u.pn * 256 + wc * 32 + 8 * fq;
#pragma unroll
        for (int ai = 0; ai < 2; ++ai)
#pragma unroll
            for (int mp = 0; mp < 2; ++mp) {
                f32x4 xv[2][2][2];
#pragma unroll
                for (int mm = 0; mm < 2; ++mm) { const size_t o = (size_t)(row0 + ai * 128 + (2 * mp + mm) * 16) * D + col0;
#pragma unroll
                    for (int bj = 0; bj < 2; ++bj) { const u32x4 dd = *(const u32x4*)(x3b + o + bj * 128);
                        xv[mm][bj][0] = (f32x4){bflo(dd.x), bfhi(dd.x), bflo(dd.y), bfhi(dd.y)}; xv[mm][bj][1] = (f32x4){bflo(dd.z), bfhi(dd.z), bflo(dd.w), bfhi(dd.w)}; } }
#pragma unroll
                for (int mm = 0; mm < 2; ++mm) { const int m = 2 * mp + mm, row = row0 + ai * 128 + m * 16; const size_t o = (size_t)row * D + col0; float ss = 0.f;
#pragma unroll
                    for (int bj = 0; bj < 2; ++bj) {
                        const f32x4 y0 = xv[mm][bj][0] + acc[ai][bj][m][0] * 0.5f, y1 = xv[mm][bj][1] + acc[ai][bj][m][1] * 0.5f;
#pragma unroll
                        for (int j = 0; j < 4; ++j) ss += y0[j] * y0[j] + y1[j] * y1[j];
                        *(u32x4*)(x3b + o + bj * 128) = pk8(y0, y1); }
                    ss += __shfl_xor(ss, 16); ss += __shfl_xor(ss, 32);
                    if (fq == 0) rowss[(size_t)row * 16 + u.pn * 4 + wc] = ss; }
            }
    }
};

__device__ __forceinline__ void transpose_item(const float* W, int N, int k0, int n0, const float* kscale, bf16_t* WT, int Kp, int drow0, LAS float* scr, int lane) {
    f32x4 v[8];
#pragma unroll
    for (int j = 0; j < 8; ++j) { const int q = lane + 64 * j, kk = q >> 3, c4 = q & 7; v[j] = __builtin_nontemporal_load((const f32x4*)(W + (size_t)(k0 + kk) * N + n0 + 4 * c4)); }
#pragma unroll
    for (int j = 0; j < 8; ++j) { const int q = lane + 64 * j, kk = q >> 3, c4 = q & 7; const float sc = kscale ? kscale[k0 + kk] : 1.f;
        LAS float* d = scr + kk * 33 + 4 * c4; d[0] = v[j][0] * sc; d[1] = v[j][1] * sc; d[2] = v[j][2] * sc; d[3] = v[j][3] * sc; }
    asm volatile("s_waitcnt lgkmcnt(0)" ::: "memory");
    const int c = lane & 7;
#pragma unroll
    for (int j = 0; j < 4; ++j) { const int n = (lane >> 3) + 8 * j; const LAS float* s = scr + (8 * c) * 33 + n;
        u32x4 o; o.x = cvt_pk_bf16(s[0 * 33], s[1 * 33]); o.y = cvt_pk_bf16(s[2 * 33], s[3 * 33]); o.z = cvt_pk_bf16(s[4 * 33], s[5 * 33]); o.w = cvt_pk_bf16(s[6 * 33], s[7 * 33]);
        *(u32x4*)(WT + (size_t)(drow0 + n) * Kp + k0 + 8 * c) = o; }
    asm volatile("s_waitcnt lgkmcnt(0)" ::: "memory");
}
__device__ __forceinline__ void ffn_weight_item(const float* wg, const float* wu, const float* wd, const float* kscale, bf16_t* WFA, bf16_t* WFD, LAS float* scr, int it, int lane) {
    if (it < 2816) { const int which = it / 1408, r = it % 1408, kb = r / 88, nb = r % 88, n0 = nb * 32;
        transpose_item(which ? wu : wg, FF, kb * 64, n0, kscale, WFA, D, (n0 >> 7) * 256 + (n0 & 127) + which * 128, scr, lane); }
    else { const int r = it - 2816, kb = r / 32, nb = r % 32; transpose_item(wd, D, kb * 64, nb * 32, nullptr, WFD, FF, nb * 32, scr, lane); }
}
constexpr int FFN_W_ITEMS = 3 * 1408;

constexpr int MIX_I_IN = 16 * 129, MIX_I_O = 32 * 32, MIX_W_ITEMS = MIX_I_IN + MIX_I_O;
__device__ __forceinline__ void mix_weight_item(const Params& p, LAS float* scr, int r, int lane) {
    if (r < MIX_I_IN) { const int kb = r / 129, nb = r % 129, n0 = nb * 32; const int drow0 = n0 < 2560 ? n0 : (n0 == 2560 ? 4096 : n0 - 32);
        transpose_item(p.in[7], 4128, kb * 64, n0, p.in[6], (bf16_t*)(p.ws + WS_WIN), D, drow0, scr, lane); return; }
    r -= MIX_I_IN;
    { const int kb = r / 32, nb = r % 32; transpose_item(p.in[17], D, kb * 64, nb * 32, nullptr, (bf16_t*)(p.ws + WS_WOUT), 2048, nb * 32, scr, lane); }
}
__device__ __forceinline__ bool mix_weights_in_p1(int G) { return ((T / 256) * (2 * FF / 256)) % G != 0; }
__device__ __forceinline__ void phase0(const Params& p, LAS unsigned char* lds, int gw, int ngw, int lane, int wave) {
    LAS float* scr = (LAS float*)(lds + wave * 16384);
    const int NIT = FFN_W_ITEMS + (mix_weights_in_p1(gridDim.x) ? 0 : MIX_W_ITEMS);
    for (int it = gw; it < NIT; it += ngw) {
        if (it < FFN_W_ITEMS) { ffn_weight_item(p.in[3], p.in[4], p.in[5], nullptr, (bf16_t*)(p.ws + WS_WFA), (bf16_t*)(p.ws + WS_WFD), scr, it, lane); continue; }
        mix_weight_item(p, scr, it - FFN_W_ITEMS, lane);
    }
    const float* nw = p.in[2]; bf16_t* XN = (bf16_t*)(p.ws + WS_XNB);
    f32x4 wv[4];
#pragma unroll
    for (int j = 0; j < 4; ++j) wv[j] = *(const f32x4*)(nw + 4 * lane + 256 * j);
    for (int m = gw; m < T; m += 2 * ngw) {
        const int m1 = m + ngw; const bool has1 = m1 < T; const int mb = has1 ? m1 : m;
        const float* xr0 = (m < TP ? p.in[0] + (size_t)m * D : p.in[1] + (size_t)(m - TP) * D) + 4 * lane;
        const float* xr1 = (mb < TP ? p.in[0] + (size_t)mb * D : p.in[1] + (size_t)(mb - TP) * D) + 4 * lane;
        f32x4 v0[4], v1[4]; float s0 = 0.f, s1 = 0.f;
#pragma unroll
        for (int j = 0; j < 4; ++j) { v0[j] = __builtin_nontemporal_load((const f32x4*)(xr0 + 256 * j)); v1[j] = __builtin_nontemporal_load((const f32x4*)(xr1 + 256 * j)); }
#pragma unroll
        for (int j = 0; j < 4; ++j) { s0 += (v0[j][0] * v0[j][0] + v0[j][1] * v0[j][1]) + (v0[j][2] * v0[j][2] + v0[j][3] * v0[j][3]); s1 += (v1[j][0] * v1[j][0] + v1[j][1] * v1[j][1]) + (v1[j][2] * v1[j][2] + v1[j][3] * v1[j][3]); }
        const float rs0 = rsqrtf(wave_sum(s0) * (1.f / D) + EPS), rs1 = rsqrtf(wave_sum(s1) * (1.f / D) + EPS);
#pragma unroll
        for (int j = 0; j < 4; ++j) *(u32x2*)(XN + (size_t)m * D + 4 * lane + 256 * j) = pk4(v0[j] * rs0 * wv[j]);
        if (has1) {
#pragma unroll
            for (int j = 0; j < 4; ++j) *(u32x2*)(XN + (size_t)m1 * D + 4 * lane + 256 * j) = pk4(v1[j] * rs1 * wv[j]); }
    }
}

__device__ __forceinline__ void dt_phase(const Params& p, const bf16_t* x1b, int gw, int ngw, int lane) {
    const bf16_t* Wdt = (const bf16_t*)(p.ws + WS_WIN) + (size_t)4096 * D;
    const float* rowss = (const float*)(p.ws + WS_SMALL); float* DT = (float*)(p.ws + WS_DT);
    const int fr = lane & 15, fq = lane >> 4;
    for (int t32 = gw; t32 < T / 32; t32 += ngw) {
        const int row0 = t32 * 32 + fr;
        const bf16_t* ap = x1b + (size_t)row0 * D + 8 * fq; const bf16_t* bp = Wdt + (size_t)fr * D + 8 * fq;
        f32x4 acc[2][2];
#pragma unroll
        for (int a = 0; a < 2; ++a) { acc[a][0] = (f32x4){0.f, 0.f, 0.f, 0.f}; acc[a][1] = acc[a][0]; }
#pragma unroll 8
        for (int ks = 0; ks < 32; ++ks) { const bf16x8 a0 = *(const bf16x8*)(ap + ks * 32), a1 = *(const bf16x8*)(ap + 16 * D + ks * 32), b0 = *(const bf16x8*)(bp + ks * 32), b1 = *(const bf16x8*)(bp + 16 * D + ks * 32);
            acc[0][0] = mfma16(b0, a0, acc[0][0]); acc[0][1] = mfma16(b1, a0, acc[0][1]); acc[1][0] = mfma16(b0, a1, acc[1][0]); acc[1][1] = mfma16(b1, a1, acc[1][1]); }
#pragma unroll
        for (int a = 0; a < 2; ++a) { const int row = row0 + 16 * a; const float rs = row_rs(rowss, row);
#pragma unroll
            for (int nt = 0; nt < 2; ++nt) { const int col = nt * 16 + 4 * fq; const float* bias = (nt ? p.in[11] : p.in[10]) + 4 * fq; f32x4 o;
#pragma unroll
                for (int j = 0; j < 4; ++j) { const float v = acc[a][nt][j] * rs + bias[j]; o[j] = v > 20.f ? v : log1pf(__expf(v)); }
                *(f32x4*)(DT + (size_t)row * 32 + col) = o; } }
    }
}

struct ConvW { f32x4 w[5][2]; f32x4 b[2]; };
__device__ __forceinline__ void load_convw(ConvW& cw, const float* conv_w, const float* conv_b, int c) {
#pragma unroll
    for (int k = 0; k < 5; ++k) { cw.w[k][0] = *(const f32x4*)(conv_w + k * 1536 + c); cw.w[k][1] = *(const f32x4*)(conv_w + k * 1536 + c + 4); }
    cw.b[0] = *(const f32x4*)(conv_b + c); cw.b[1] = *(const f32x4*)(conv_b + c + 4);
}
__device__ __forceinline__ void conv8x2(const bf16_t* xbc, int row, int lo, int hi, int c, const ConvW& cw, f32x4& o0a, f32x4& o0b, f32x4& o1a, f32x4& o1b) {
    f32x4 xa[6], xb[6];
#pragma unroll
    for (int k = 0; k < 6; ++k) { const int r = row + k - 2; const bool ok = (r >= lo) && (r < hi); const int rc = ok ? r : row;
        u32x4 v = *(const u32x4*)(xbc + (size_t)rc * 1536 + c); if (!ok) v = (u32x4){0u, 0u, 0u, 0u};
        xa[k] = (f32x4){bflo(v.x), bfhi(v.x), bflo(v.y), bfhi(v.y)}; xb[k] = (f32x4){bflo(v.z), bfhi(v.z), bflo(v.w), bfhi(v.w)}; }
    o0a = cw.b[0]; o0b = cw.b[1]; o1a = cw.b[0]; o1b = cw.b[1];
#pragma unroll
    for (int k = 0; k < 5; ++k) { o0a += xa[k] * cw.w[k][0]; o0b += xb[k] * cw.w[k][1]; o1a += xa[k + 1] * cw.w[k][0]; o1b += xb[k + 1] * cw.w[k][1]; }
#pragma unroll
    for (int j = 0; j < 4; ++j) { o0a[j] = silu_f(o0a[j]); o0b[j] = silu_f(o0b[j]); o1a[j] = silu_f(o1a[j]); o1b[j] = silu_f(o1b[j]); }
}

#define LBAR() do { asm volatile("s_waitcnt lgkmcnt(0)" ::: "memory"); __builtin_amdgcn_s_barrier(); asm volatile("" ::: "memory"); } while (0)
__device__ __forceinline__ int rho128(int n) { return ((n >> 2) & 7) * 16 + (n >> 5) * 4 + (n & 3); }
__device__ __forceinline__ void ssd_states_item(const Params& p, LAS unsigned char* lds, int cidx, int g, bool fill_wl) {
    int tid = threadIdx.x; asm volatile("" : "+v"(tid));
    const int lane = tid & 63, wave = __builtin_amdgcn_readfirstlane(tid >> 6), fr = lane & 15, fq = lane >> 4;
    LAS float* DTs = (LAS float*)lds;
    LAS float* Ws = DTs + 2048;
    LAS bf16_t* BT = (LAS bf16_t*)(lds + 16384);
    LAS bf16_t* XT0 = BT + 128 * 136;
    LAS bf16_t* WL = XT0 + 4 * 64 * 136;
    const bf16_t* XBC = (const bf16_t*)(p.ws + WS_XBC); const float* DT = (const float*)(p.ws + WS_DT);
    float* CHDEC = (float*)(p.ws + WS_CHDEC); bf16_t* ST = (bf16_t*)p.out;
    const int t0 = cidx * 128, lo = (cidx >> 6) * SEQL, hi = lo + SEQL;
    const int c8 = wave, prow = t0 + 2 * lane;
    u32x4 raw[6]; unsigned keep[8];
    const bf16_t* HALO = (const bf16_t*)(p.ws + WS_HALO); bf16_t* XBCw = (bf16_t*)(p.ws + WS_XBC);
#define A_ISSUE(hh) do { \
        _Pragma("unroll") for (int k = 0; k < 6; ++k) { const int r = prow + k - 2; const bool ok = (r >= lo) && (r < hi); const int colx = g * 512 + (hh) * 64 + c8 * 8; \
            const bf16_t* src = r < t0 ? HALO + ((size_t)(cidx - 1) * 4 + 2 + (r - (t0 - 2))) * 1024 + colx : (r >= t0 + 128 ? HALO + ((size_t)(cidx + 1) * 4 + (r - (t0 + 128))) * 1024 + colx : XBC + (size_t)r * 1536 + colx); \
            raw[k] = *(const u32x4*)(ok ? src : XBC + (size_t)prow * 1536 + colx); if (!ok) raw[k] = (u32x4){0u, 0u, 0u, 0u}; } } while (0)
    __syncthreads();
    A_ISSUE(0);
    for (int i = tid; i < 2048; i += 512) { const int l = i >> 4, j = i & 15; DTs[j * 128 + l] = DT[(size_t)(t0 + l) * 32 + (j >> 3) * 16 + g * 8 + (j & 7)]; }
    if (fill_wl) for (int i = tid; i < 3072; i += 512) { const int k = (i >> 6) % 6, c = (i / 384) * 64 + (i & 63); const float v = k < 5 ? p.in[8][k * 1536 + g * 512 + c] : p.in[9][g * 512 + c];
        WL[i] = (bf16_t)(cvt_pk_bf16(v, 0.f) & 0xffffu); }
    { f32x4 a0, b0, a1, b1, e0, f0, e1, f1; const int cbA = wave, cbB = wave + 8;
        { ConvW cw; load_convw(cw, p.in[8], p.in[9], 1024 + g * 128 + cbA * 8); conv8x2(XBC, t0 + 2 * lane, lo, hi, 1024 + g * 128 + cbA * 8, cw, a0, b0, a1, b1); }
        { ConvW cw; load_convw(cw, p.in[8], p.in[9], 1024 + g * 128 + cbB * 8); conv8x2(XBC, t0 + 2 * lane, lo, hi, 1024 + g * 128 + cbB * 8, cw, e0, f0, e1, f1); }
#pragma unroll
        for (int i = 0; i < 4; ++i) { *(LAS unsigned*)(BT + rho128(cbA * 8 + i) * 136 + 2 * lane) = cvt_pk_bf16(a0[i], a1[i]); *(LAS unsigned*)(BT + rho128(cbA * 8 + 4 + i) * 136 + 2 * lane) = cvt_pk_bf16(b0[i], b1[i]);
            *(LAS unsigned*)(BT + rho128(cbB * 8 + i) * 136 + 2 * lane) = cvt_pk_bf16(e0[i], e1[i]); *(LAS unsigned*)(BT + rho128(cbB * 8 + 4 + i) * 136 + 2 * lane) = cvt_pk_bf16(f0[i], f1[i]); } }
    LBAR();
#pragma unroll
    for (int cc = 0; cc < 2; ++cc) { const int col = 2 * wave + cc, dir = col >> 3, h = col & 7; const float a = -__expf((dir ? p.in[13] : p.in[12])[g * 8 + h]);
        const float d0 = DTs[col * 128 + 2 * lane], d1 = DTs[col * 128 + 2 * lane + 1], v0 = d0 * a, v1 = d1 * a; float x = v0 + v1;
#pragma unroll
        for (int o = 1; o < 64; o <<= 1) { const float t = __shfl_up(x, o); if (lane >= o) x += t; }
        const float tot = __shfl(x, 63);
        const float e0 = dir == 0 ? tot - (x - v1) : x - v0 - v1, e1 = dir == 0 ? tot - x : x - v1;
        Ws[col * 128 + 2 * lane] = d0 * __expf(e0); Ws[col * 128 + 2 * lane + 1] = d1 * __expf(e1);
        if (lane == 0) CHDEC[(cidx * 2 + dir) * 16 + g * 8 + h] = __expf(tot); }
#define A_CONV(hh, XF, XB) do { \
        int tid_h = tid; asm volatile("" : "+v"(tid_h)); \
        const int lane = tid_h & 63, prow = t0 + 2 * lane; \
        f32x4 o0a, o0b, o1a, o1b; f32x4 xa[6], xb[6]; \
        _Pragma("unroll") for (int k = 0; k < 6; ++k) { xa[k] = (f32x4){bflo(raw[k].x), bfhi(raw[k].x), bflo(raw[k].y), bfhi(raw[k].y)}; xb[k] = (f32x4){bflo(raw[k].z), bfhi(raw[k].z), bflo(raw[k].w), bfhi(raw[k].w)}; } \
        { const u32x4 bw = *(const LAS u32x4*)(WL + ((hh) * 6 + 5) * 64 + c8 * 8); o0a = (f32x4){bflo(bw.x), bfhi(bw.x), bflo(bw.y), bfhi(bw.y)}; o0b = (f32x4){bflo(bw.z), bfhi(bw.z), bflo(bw.w), bfhi(bw.w)}; o1a = o0a; o1b = o0b; } \
        _Pragma("unroll") for (int k = 0; k < 5; ++k) { const u32x4 ww = *(const LAS u32x4*)(WL + ((hh) * 6 + k) * 64 + c8 * 8); \
            const f32x4 wa = {bflo(ww.x), bfhi(ww.x), bflo(ww.y), bfhi(ww.y)}, wb = {bflo(ww.z), bfhi(ww.z), bflo(ww.w), bfhi(ww.w)}; \
            o0a += xa[k] * wa; o0b += xb[k] * wb; o1a += xa[k + 1] * wa; o1b += xb[k + 1] * wb; } \
        if ((hh) < 7) A_ISSUE((hh) + 1); \
        const float wf0 = Ws[(hh) * 128 + 2 * lane], wf1 = Ws[(hh) * 128 + 2 * lane + 1], wb0 = Ws[(8 + (hh)) * 128 + 2 * lane], wb1 = Ws[(8 + (hh)) * 128 + 2 * lane + 1]; \
        _Pragma("unroll") for (int i = 0; i < 4; ++i) { const float s0a = silu_f(o0a[i]), s1a = silu_f(o1a[i]), s0b = silu_f(o0b[i]), s1b = silu_f(o1b[i]); \
            keep[i] = cvt_pk_bf16(s0a, s1a); keep[4 + i] = cvt_pk_bf16(s0b, s1b); \
            *(LAS unsigned*)((XF) + (c8 * 8 + i) * 136 + 2 * lane) = cvt_pk_bf16(s0a * wf0, s1a * wf1); *(LAS unsigned*)((XF) + (c8 * 8 + 4 + i) * 136 + 2 * lane) = cvt_pk_bf16(s0b * wf0, s1b * wf1); \
            *(LAS unsigned*)((XB) + (c8 * 8 + i) * 136 + 2 * lane) = cvt_pk_bf16(s0a * wb0, s1a * wb1); *(LAS unsigned*)((XB) + (c8 * 8 + 4 + i) * 136 + 2 * lane) = cvt_pk_bf16(s0b * wb0, s1b * wb1); } } while (0)
#define A_MMA(hh, XF, XB) do { \
        int tid_h = tid; asm volatile("" : "+v"(tid_h)); \
        const int lane = tid_h & 63, fr = lane & 15, fq = lane >> 4; \
        const int dir = wave >> 2, pt = wave & 3; const LAS bf16_t* A = (dir ? (XB) : (XF)) + (pt * 16 + fr) * 136 + 8 * fq; const LAS bf16_t* B = BT + fr * 136 + 8 * fq; \
        f32x4 acc[8]; \
        _Pragma("unroll") for (int nt = 0; nt < 8; ++nt) acc[nt] = (f32x4){0.f, 0.f, 0.f, 0.f}; \
        _Pragma("unroll") for (int ks = 0; ks < 4; ++ks) { const bf16x8 a = *(const LAS bf16x8*)(A + ks * 32); \
            _Pragma("unroll") for (int nt = 0; nt < 8; ++nt) acc[nt] = mfma16(*(const LAS bf16x8*)(B + nt * 16 * 136 + ks * 32), a, acc[nt]); } \
        bf16_t* dst = ST + ((size_t)((cidx * 2 + dir) * 16 + g * 8 + (hh)) * 64 + pt * 16 + fr) * 128 + 32 * fq; \
        _Pragma("unroll") for (int nt = 0; nt < 8; nt += 2) *(u32x4*)(dst + nt * 4) = pk8(acc[nt], acc[nt + 1]); } while (0)
#define A_WRITEBACK(hh) do { \
        int tid_w = tid; asm volatile("" : "+v"(tid_w)); const int lw = tid_w & 63; \
        _Pragma("unroll") for (int i = 0; i < 8; ++i) *(unsigned*)(XBCw + (size_t)(t0 + 2 * (c8 * 8 + i) + (lw >> 5)) * 1536 + g * 512 + (hh) * 64 + ((2 * lw) & 63)) = keep[i]; } while (0)
    LBAR();
    A_CONV(0, XT0, XT0 + 64 * 136);
    LBAR();
#pragma unroll 1
    for (int h = 0; h < 8; ++h) {
        LAS bf16_t* cur = XT0 + (h & 1) * (2 * 64 * 136); LAS bf16_t* nxt = XT0 + ((h + 1) & 1) * (2 * 64 * 136);
        A_WRITEBACK(h);
#pragma unroll 1
        for (int st = 0; st < 2; ++st) {
            if ((st == 0) == (wave < 4)) { if (h < 7) A_CONV(h + 1, nxt, nxt + 64 * 136); }
            else A_MMA(h, cur, cur + 64 * 136); }
        LBAR();
    }
#undef A_CONV
#undef A_MMA
#undef A_WRITEBACK
#undef A_ISSUE
}

__device__ __forceinline__ void ssd_scan_phase(const Params& p) {
    bf16_t* ST = (bf16_t*)p.out; const float* CHDEC = (const float*)(p.ws + WS_CHDEC);
    for (int it = blockIdx.x * 512 + threadIdx.x; it < 6 * 2 * 16 * 1024; it += gridDim.x * 512) {
        const int e8 = it & 1023, head = (it >> 10) & 15, dir = (it >> 14) & 1, seq = it >> 15;
        f32x4 c0 = {0.f, 0.f, 0.f, 0.f}, c1 = c0;
#pragma unroll 1
        for (int sb = 0; sb < 8; ++sb) {
            u32x4 v[8]; float dec[8];
#pragma unroll
            for (int k = 0; k < 8; ++k) { const int step = sb * 8 + k, cidx = seq * 64 + (dir ? 63 - step : step);
                v[k] = *(const u32x4*)(ST + ((size_t)((cidx * 2 + dir) * 16 + head) * 8192) + e8 * 8); dec[k] = CHDEC[(cidx * 2 + dir) * 16 + head]; }
#pragma unroll
            for (int k = 0; k < 8; ++k) { const int step = sb * 8 + k, cidx = seq * 64 + (dir ? 63 - step : step);
                *(u32x4*)(ST + ((size_t)((cidx * 2 + dir) * 16 + head) * 8192) + e8 * 8) = pk8(c0, c1);
                c0 = c0 * dec[k] + (f32x4){bflo(v[k].x), bfhi(v[k].x), bflo(v[k].y), bfhi(v[k].y)}; c1 = c1 * dec[k] + (f32x4){bflo(v[k].z), bfhi(v[k].z), bflo(v[k].w), bfhi(v[k].w)}; }
        }
    }
}

__device__ __forceinline__ int rho64(int pcol) { return ((pcol >> 2) & 3) * 16 + (pcol >> 4) * 4 + (pcol & 3); }
__device__ __forceinline__ void ssd_out_item(const Params& p, LAS unsigned char* lds, int cidx, int g) {
    int tid = threadIdx.x; asm volatile("" : "+v"(tid));
    const int lane = tid & 63, wave = __builtin_amdgcn_readfirstlane(tid >> 6), fr = lane & 15, fq = lane >> 4;
    LAS float* DTF = (LAS float*)lds; LAS float* DTB = DTF + 1024; LAS float* CSF = DTB + 1024; LAS float* SFB = CSF + 1024;
    LAS bf16_t* Cm = (LAS bf16_t*)(lds + 16384);
    LAS bf16_t* Bm = Cm + 128 * 136;
    LAS bf16_t* XT = Bm + 128 * 136;
    LAS bf16_t* PF = XT + 64 * 136; LAS bf16_t* PB = PF + 64 * 136;
    LAS bf16_t* WL = PB + 64 * 136;
    const bf16_t* XBC = (const bf16_t*)(p.ws + WS_XBC); const float* DT = (const float*)(p.ws + WS_DT);
    const bf16_t* ST = (const bf16_t*)p.out; bf16_t* ZQ = (bf16_t*)(p.ws + WS_ZQ);
    const int t0 = cidx * 128, lo = (cidx >> 6) * SEQL, hi = lo + SEQL;
    __syncthreads();
    const bool first_item = (cidx == 0 && g == 0); ISTAMP(first_item, 24);
    for (int i = tid; i < 2048; i += 512) { const int l = i >> 4, j = i & 15; DTF[j * 128 + l] = DT[(size_t)(t0 + l) * 32 + (j >> 3) * 16 + g * 8 + (j & 7)]; }
#pragma unroll 1
    for (int rep = 0; rep < 2; ++rep) { const int c8 = wave + 8 * rep, colB = 1024 + g * 128 + c8 * 8, colC = colB + 256;
        f32x4 a0, b0, a1, b1, e0, f0, e1, f1;
        { ConvW cw; load_convw(cw, p.in[8], p.in[9], colB); conv8x2(XBC, t0 + 2 * lane, lo, hi, colB, cw, a0, b0, a1, b1); }
        { ConvW cw; load_convw(cw, p.in[8], p.in[9], colC); conv8x2(XBC, t0 + 2 * lane, lo, hi, colC, cw, e0, f0, e1, f1); }
        LAS bf16_t* dB = Bm + (2 * lane) * 136 + c8 * 8; LAS bf16_t* dC = Cm + (2 * lane) * 136 + c8 * 8;
        *(LAS u32x4*)dB = pk8(a0, b0); *(LAS u32x4*)(dB + 136) = pk8(a1, b1); *(LAS u32x4*)dC = pk8(e0, f0); *(LAS u32x4*)(dC + 136) = pk8(e1, f1); }
    __syncthreads();
#pragma unroll
    for (int cc = 0; cc < 2; ++cc) { const int col = 2 * wave + cc, dir = col >> 3, h = col & 7; const float a = -__expf((dir ? p.in[13] : p.in[12])[g * 8 + h]);
        const float v0 = DTF[col * 128 + 2 * lane] * a, v1 = DTF[col * 128 + 2 * lane + 1] * a; float x = v0 + v1;
#pragma unroll
        for (int o = 1; o < 64; o <<= 1) { const float t = __shfl_up(x, o); if (lane >= o) x += t; }
        const float tot = __shfl(x, 63);
        if (dir == 0) { CSF[h * 128 + 2 * lane] = x - v1; CSF[h * 128 + 2 * lane + 1] = x; }
        else { SFB[h * 128 + 2 * lane] = tot - x + v0 + v1; SFB[h * 128 + 2 * lane + 1] = tot - x + v1; } }
    f32x4 cb[8];
    { const LAS bf16_t* A = Cm + (wave * 16 + fr) * 136 + 8 * fq; const LAS bf16_t* B = Bm + fr * 136 + 8 * fq;
#pragma unroll
      for (int nt = 0; nt < 8; ++nt) cb[nt] = (f32x4){0.f, 0.f, 0.f, 0.f};
#pragma unroll
      for (int ks = 0; ks < 4; ++ks) { const bf16x8 a = *(const LAS bf16x8*)(A + ks * 32);
#pragma unroll
          for (int nt = 0; nt < 8; ++nt) cb[nt] = mfma16(*(const LAS bf16x8*)(B + nt * 16 * 136 + ks * 32), a, cb[nt]); } }
    const int l = wave * 16 + fr; const size_t zrow = (size_t)(t0 + l) * 2048 + g * 512;
    float ss = 0.f;
    const int c8 = wave; const int prow = t0 + 2 * lane;
    u32x4 raw[2], prv[4];
#define C_ISSUE(hh) do { \
        _Pragma("unroll") for (int k = 0; k < 2; ++k) { const int q = tid + 512 * k, pp = q >> 4, l0 = (q & 15) * 8; raw[k] = *(const u32x4*)(XBC + (size_t)(t0 + 2 * pp + (l0 >> 6)) * 1536 + g * 512 + (hh) * 64 + (l0 & 63)); } \
        _Pragma("unroll") for (int k = 0; k < 4; ++k) { const int i = tid + 512 * k, which = i >> 10, r = (i >> 4) & 63, c = i & 15; prv[k] = *(const u32x4*)(ST + ((size_t)((cidx * 2 + which) * 16 + g * 8 + (hh)) * 64 + r) * 128 + c * 8); } \
        } while (0)
    C_ISSUE(0);
    ISTAMP(first_item, 25);
#pragma unroll 1
    for (int h = 0; h < 8; ++h) {
        LBAR();
        int tid_h = tid; asm volatile("" : "+v"(tid_h));
        const int tid = tid_h, lane = tid & 63, fr = lane & 15, fq = lane >> 4, l = wave * 16 + fr, prow = t0 + 2 * lane; const size_t zrow = (size_t)(t0 + l) * 2048 + g * 512;
#pragma unroll
        for (int k = 0; k < 2; ++k) { const int q = tid + 512 * k, pp = q >> 4, l0 = (q & 15) * 8; *(LAS u32x4*)(XT + rho64(pp) * 136 + l0) = raw[k]; }
#pragma unroll
        for (int k = 0; k < 4; ++k) { const int i = tid + 512 * k, which = i >> 10, r = (i >> 4) & 63, c = i & 15; *(LAS u32x4*)((which ? PB : PF) + rho64(r) * 136 + c * 8) = prv[k]; }
        if (h < 7) C_ISSUE(h + 1);
        const float csl = CSF[h * 128 + l], sbl = SFB[h * 128 + l], dtl = DTF[h * 128 + l] + DTB[h * 128 + l], dsk = p.in[14][g * 8 + h];
#pragma unroll
        for (int nt = 0; nt < 8; ++nt) { const int s0 = nt * 16 + 4 * fq; f32x4 gv;
            if (nt < wave) { const f32x4 cs4 = *(const LAS f32x4*)(CSF + h * 128 + s0), df4 = *(const LAS f32x4*)(DTF + h * 128 + s0);
#pragma unroll
                for (int r = 0; r < 4; ++r) gv[r] = cb[nt][r] * (__expf(csl - cs4[r]) * df4[r]); }
            else if (nt > wave) { const f32x4 sb4 = *(const LAS f32x4*)(SFB + h * 128 + s0), db4 = *(const LAS f32x4*)(DTB + h * 128 + s0);
#pragma unroll
                for (int r = 0; r < 4; ++r) gv[r] = cb[nt][r] * (__expf(sbl - sb4[r]) * db4[r]); }
            else { const f32x4 cs4 = *(const LAS f32x4*)(CSF + h * 128 + s0), df4 = *(const LAS f32x4*)(DTF + h * 128 + s0), sb4 = *(const LAS f32x4*)(SFB + h * 128 + s0), db4 = *(const LAS f32x4*)(DTB + h * 128 + s0);
#pragma unroll
                for (int r = 0; r < 4; ++r) { const int s = s0 + r; const float e = __expf(s < l ? csl - cs4[r] : sbl - sb4[r]) * (s < l ? df4[r] : db4[r]); gv[r] = cb[nt][r] * (s == l ? dtl : e) + (s == l ? dsk : 0.f); } }
            *(LAS u32x2*)(Bm + l * 136 + s0) = pk4(gv); }
        LBAR();
        const u32x4 z0 = *(const u32x4*)(ZQ + zrow + h * 64 + 16 * fq), z1 = *(const u32x4*)(ZQ + zrow + h * 64 + 16 * fq + 8);
        f32x4 aY[4], aF[4], aB[4];
#pragma unroll
        for (int d = 0; d < 4; ++d) { aY[d] = (f32x4){0.f, 0.f, 0.f, 0.f}; aF[d] = aY[d]; aB[d] = aY[d]; }
#pragma unroll
        for (int ks = 0; ks < 4; ++ks) { const bf16x8 ag = *(const LAS bf16x8*)(Bm + l * 136 + ks * 32 + 8 * fq), ac = *(const LAS bf16x8*)(Cm + l * 136 + ks * 32 + 8 * fq);
#pragma unroll
            for (int d = 0; d < 4; ++d) { const int bo = (d * 16 + fr) * 136 + ks * 32 + 8 * fq;
                aY[d] = mfma16(*(const LAS bf16x8*)(XT + bo), ag, aY[d]); aF[d] = mfma16(*(const LAS bf16x8*)(PF + bo), ac, aF[d]); aB[d] = mfma16(*(const LAS bf16x8*)(PB + bo), ac, aB[d]);
                if (d & 1) asm volatile("" ::: "memory"); } }
        const float ef = __expf(csl), eb = __expf(sbl);
        f32x4 y[4];
        { const unsigned zz[8] = {z0.x, z0.y, z0.z, z0.w, z1.x, z1.y, z1.z, z1.w};
#pragma unroll
          for (int d = 0; d < 4; ++d) { y[d] = aY[d] + aF[d] * ef + aB[d] * eb;
              const f32x4 z4 = {bflo(zz[2 * d]), bfhi(zz[2 * d]), bflo(zz[2 * d + 1]), bfhi(zz[2 * d + 1])};
#pragma unroll
              for (int j = 0; j < 4; ++j) { y[d][j] *= silu_f(z4[j]); ss += y[d][j] * y[d][j]; } } }
        *(u32x4*)(ZQ + zrow + h * 64 + 16 * fq) = pk8(y[0], y[1]); *(u32x4*)(ZQ + zrow + h * 64 + 16 * fq + 8) = pk8(y[2], y[3]);
    }
#undef C_ISSUE
    ISTAMP(first_item, 26);
    ss += __shfl_xor(ss, 16); ss += __shfl_xor(ss, 32);
    const float rstd = rsqrtf(ss * (1.f / 512.f) + EPS); const float* nw = p.in[15] + g * 512;
    u32x4 yv[16];
#pragma unroll
    for (int i = 0; i < 16; ++i) yv[i] = *(const u32x4*)(ZQ + zrow + (i >> 1) * 64 + 16 * fq + (i & 1) * 8);
#pragma unroll
    for (int i = 0; i < 16; ++i) { const int pc = (i >> 1) * 64 + 16 * fq + (i & 1) * 8; const f32x4 w0 = *(const f32x4*)(nw + pc), w1 = *(const f32x4*)(nw + pc + 4);
        const f32x4 ya = {bflo(yv[i].x) * rstd * w0[0], bfhi(yv[i].x) * rstd * w0[1], bflo(yv[i].y) * rstd * w0[2], bfhi(yv[i].y) * rstd * w0[3]};
        const f32x4 yb = {bflo(yv[i].z) * rstd * w1[0], bfhi(yv[i].z) * rstd * w1[1], bflo(yv[i].w) * rstd * w1[2], bfhi(yv[i].w) * rstd * w1[3]};
        *(u32x4*)(ZQ + zrow + pc) = pk8(ya, yb); }
    ISTAMP(first_item, 27);
}

struct AttnPre { u32x4 k[6], v0[3], v1[3]; };
__device__ __forceinline__ void attn_issue(const Params& p, AttnPre& pre, int tid, int lane, int wave, int seq, int qb, int kvh) {
    const bf16_t* KV = (const bf16_t*)(p.ws + WS_KV); const int qs = qb * 128, rowbase = seq * SEQL;
#pragma unroll
    for (int it = 0; it < 6; ++it) { const int idx = tid + 512 * it, j = idx >> 3, c = idx & 7, sp = qs - 128 + j; const bool ok = sp >= 0 && sp < SEQL;
        pre.k[it] = *(const u32x4*)(KV + (size_t)(rowbase + (ok ? sp : qs)) * 512 + kvh * 64 + c * 8); if (!ok) pre.k[it] = (u32x4){0u, 0u, 0u, 0u}; }
#pragma unroll
    for (int it = 0; it < 3; ++it) { const int j0 = 2 * (lane + 64 * it), sp = qs - 128 + j0; const bool ok = sp >= 0 && sp < SEQL;
        const bf16_t* src = KV + (size_t)(rowbase + (ok ? sp : qs)) * 512 + 256 + kvh * 64 + wave * 8;
        pre.v0[it] = *(const u32x4*)src; pre.v1[it] = *(const u32x4*)(src + 512); if (!ok) { pre.v0[it] = (u32x4){0u, 0u, 0u, 0u}; pre.v1[it] = pre.v0[it]; } }
}
template <int NT0, int NT1>
__device__ __forceinline__ void attn_block(const LAS bf16_t* Ks, const LAS bf16_t* VT, int kb, int c0, int fr, int fq, float basef, float slope2, float sc2,
                                           const bf16x8 q0, const bf16x8 q1, f32x4 (&O)[4], float& mrun, float& lrun) {
    f32x4 s[8];
#pragma unroll
    for (int nt = NT0; nt < NT1; ++nt) { s[nt] = (f32x4){0.f, 0.f, 0.f, 0.f};
        s[nt] = mfma16(*(const LAS bf16x8*)(Ks + (kb * 128 + nt * 16 + fr) * 72 + 8 * fq), q0, s[nt]);
        s[nt] = mfma16(*(const LAS bf16x8*)(Ks + (kb * 128 + nt * 16 + fr) * 72 + 32 + 8 * fq), q1, s[nt]); }
    float tmax = -INFINITY;
#pragma unroll
    for (int nt = NT0; nt < NT1; ++nt) { const int c = c0 - 16 * nt; const float scf = ((float)c + basef) * slope2;
        const float thr = (c > 128 || c < -128) ? -1.f : ((c == 128 || c == -128) ? 128.5f * slope2 : INFINITY);
#pragma unroll
        for (int r = 0; r < 4; ++r) { const float at = fabsf(scf - slope2 * (float)r); const float v = at > thr ? -INFINITY : fmaf(s[nt][r], sc2, -at); s[nt][r] = v; tmax = fmaxf(tmax, v); } }
    tmax = fmaxf(tmax, __shfl_xor(tmax, 16)); tmax = fmaxf(tmax, __shfl_xor(tmax, 32));
    const float mnew = fmaxf(mrun, tmax), alpha = __builtin_amdgcn_exp2f(mrun - mnew); float rsum = 0.f;
#pragma unroll
    for (int nt = NT0; nt < NT1; ++nt)
#pragma unroll
        for (int r = 0; r < 4; ++r) { const float pv = __builtin_amdgcn_exp2f(s[nt][r] - mnew); s[nt][r] = pv; rsum += pv; }
    rsum += __shfl_xor(rsum, 16); rsum += __shfl_xor(rsum, 32);
    lrun = lrun * alpha + rsum; mrun = mnew;
#pragma unroll
    for (int d = 0; d < 4; ++d) O[d] *= alpha;
#pragma unroll
    for (int k = NT0 / 2; k < NT1 / 2; ++k) {
        const u32x2 pa = pk4(s[2 * k]), pb = pk4(s[2 * k + 1]); const u32x4 pw = {pa.x, pa.y, pb.x, pb.y}; const bf16x8 pf = __builtin_bit_cast(bf16x8, pw);
#pragma unroll
        for (int d = 0; d < 4; ++d) { const LAS bf16_t* vp = VT + (d * 16 + fr) * 392 + kb * 128 + k * 32 + 4 * fq;
            const u32x2 va = *(const LAS u32x2*)vp, vb = *(const LAS u32x2*)(vp + 16); const u32x4 vw = {va.x, va.y, vb.x, vb.y};
            O[d] = mfma16(__builtin_bit_cast(bf16x8, vw), pf, O[d]); } }
}
__device__ __forceinline__ void attn_item(const Params& p, LAS unsigned char* lds, AttnPre& pre, int seq, int qb, int kvh, int nseq, int nqb, int nkvh) {
    int tid = threadIdx.x; asm volatile("" : "+v"(tid));
    const int lane = tid & 63, wave = __builtin_amdgcn_readfirstlane(tid >> 6), fr = lane & 15, fq = lane >> 4;
    LAS bf16_t* Ks = (LAS bf16_t*)lds;
    LAS bf16_t* VT = Ks + 384 * 72;
    LAS bf16_t* Pw = VT + 64 * 392 + wave * (16 * 136);
    bf16_t* ZQ = (bf16_t*)(p.ws + WS_ZQ);
    const int qs = qb * 128, rowbase = seq * SEQL;
    LBAR();
#pragma unroll
    for (int it = 0; it < 6; ++it) { const int idx = tid + 512 * it, j = idx >> 3, c = idx & 7; *(LAS u32x4*)(Ks + j * 72 + c * 8) = pre.k[it]; }
#pragma unroll
    for (int it = 0; it < 3; ++it) { const int j0 = 2 * (lane + 64 * it); const u32x4 v0 = pre.v0[it], v1 = pre.v1[it];
        LAS bf16_t* dst = VT + (wave * 8) * 392 + j0;
        *(LAS unsigned*)(dst + 0 * 392) = (v0.x & 0xffffu) | (v1.x << 16); *(LAS unsigned*)(dst + 1 * 392) = (v0.x >> 16) | (v1.x & 0xffff0000u);
        *(LAS unsigned*)(dst + 2 * 392) = (v0.y & 0xffffu) | (v1.y << 16); *(LAS unsigned*)(dst + 3 * 392) = (v0.y >> 16) | (v1.y & 0xffff0000u);
        *(LAS unsigned*)(dst + 4 * 392) = (v0.z & 0xffffu) | (v1.z << 16); *(LAS unsigned*)(dst + 5 * 392) = (v0.z >> 16) | (v1.z & 0xffff0000u);
        *(LAS unsigned*)(dst + 6 * 392) = (v0.w & 0xffffu) | (v1.w << 16); *(LAS unsigned*)(dst + 7 * 392) = (v0.w >> 16) | (v1.w & 0xffff0000u); }
    const int hq = kvh * 4 + (wave >> 1), r0 = qs + 64 * (wave & 1);
    bf16_t* qbase = ZQ + (size_t)(rowbase + r0 + fr) * 2048 + 1024 + hq * 64;
    bf16x8 qf[4][2];
#pragma unroll
    for (int mt = 0; mt < 4; ++mt)
#pragma unroll
        for (int k = 0; k < 2; ++k) qf[mt][k] = *(const bf16x8*)(qbase + (size_t)mt * 16 * 2048 + k * 32 + 8 * fq);
    if (nseq >= 0) attn_issue(p, pre, tid, lane, wave, nseq, nqb, nkvh);
    LBAR();
    const float slope2 = __builtin_amdgcn_exp2f(-0.5f * (float)(hq + 1)) * LOG2E, sink2 = p.in[16][hq] * LOG2E, sc2 = 0.125f * LOG2E;
    const float basef = (float)(fr - 4 * fq); const int half = wave & 1;
#pragma unroll 1
    for (int mt = 0; mt < 4; ++mt) {
        const bf16x8 q0 = mt == 0 ? qf[0][0] : (mt == 1 ? qf[1][0] : (mt == 2 ? qf[2][0] : qf[3][0]));
        const bf16x8 q1 = mt == 0 ? qf[0][1] : (mt == 1 ? qf[1][1] : (mt == 2 ? qf[2][1] : qf[3][1]));
        f32x4 O[4]; float mrun = sink2, lrun = 1.f;
#pragma unroll
        for (int d = 0; d < 4; ++d) O[d] = (f32x4){0.f, 0.f, 0.f, 0.f};
#pragma unroll 1
        for (int kb = 0; kb < 3; ++kb) {
            if ((kb == 0 && qb == 0) || (kb == 2 && qb == 63)) continue;
            const int c0 = 64 * half + 16 * mt + 128 - 128 * kb;
            if (c0 - 112 > 128 || c0 < -128) continue;
            if (c0 - 48 > 128) attn_block<4, 8>(Ks, VT, kb, c0, fr, fq, basef, slope2, sc2, q0, q1, O, mrun, lrun);
            else if (c0 - 64 < -128) attn_block<0, 4>(Ks, VT, kb, c0, fr, fq, basef, slope2, sc2, q0, q1, O, mrun, lrun);
            else attn_block<0, 8>(Ks, VT, kb, c0, fr, fq, basef, slope2, sc2, q0, q1, O, mrun, lrun);
        }
        const float inv = 1.f / lrun;
#pragma unroll
        for (int d = 0; d < 4; ++d) *(u32x2*)(qbase + (size_t)mt * 16 * 2048 + d * 16 + 4 * fq) = pk4(O[d] * inv);
    }
}

__device__ __forceinline__ void final_norm_phase(const Params& p, int gw, int ngw, int lane) {
    const float* rowss = (const float*)(p.ws + WS_SMALL) + (size_t)2 * T * 16; const float* nw = p.in[22]; const bf16_t* x3b = (const bf16_t*)(p.ws + WS_XNB);
    f32x4 w0 = *(const f32x4*)(nw + 8 * lane), w1 = *(const f32x4*)(nw + 8 * lane + 4), w2 = *(const f32x4*)(nw + 512 + 8 * lane), w3 = *(const f32x4*)(nw + 512 + 8 * lane + 4);
    for (int m = gw; m < T; m += 2 * ngw) {
        const int m1 = m + ngw; const bool has1 = m1 < T; const int mb = has1 ? m1 : m;
        const u32x4 a0 = *(const u32x4*)(x3b + (size_t)m * D + 8 * lane), b0 = *(const u32x4*)(x3b + (size_t)m * D + 512 + 8 * lane);
        const u32x4 a1 = *(const u32x4*)(x3b + (size_t)mb * D + 8 * lane), b1 = *(const u32x4*)(x3b + (size_t)mb * D + 512 + 8 * lane);
        const float rs0 = row_rs(rowss, m), rs1 = row_rs(rowss, mb);
        { float* xr = p.out + (size_t)m * D + 8 * lane;
          *(f32x4*)(xr) = (f32x4){bflo(a0.x), bfhi(a0.x), bflo(a0.y), bfhi(a0.y)} * rs0 * w0; *(f32x4*)(xr + 4) = (f32x4){bflo(a0.z), bfhi(a0.z), bflo(a0.w), bfhi(a0.w)} * rs0 * w1;
          *(f32x4*)(xr + 512) = (f32x4){bflo(b0.x), bfhi(b0.x), bflo(b0.y), bfhi(b0.y)} * rs0 * w2; *(f32x4*)(xr + 516) = (f32x4){bflo(b0.z), bfhi(b0.z), bflo(b0.w), bfhi(b0.w)} * rs0 * w3; }
        if (has1) { float* xr = p.out + (size_t)m1 * D + 8 * lane;
          *(f32x4*)(xr) = (f32x4){bflo(a1.x), bfhi(a1.x), bflo(a1.y), bfhi(a1.y)} * rs1 * w0; *(f32x4*)(xr + 4) = (f32x4){bflo(a1.z), bfhi(a1.z), bflo(a1.w), bfhi(a1.w)} * rs1 * w1;
          *(f32x4*)(xr + 512) = (f32x4){bflo(b1.x), bfhi(b1.x), bflo(b1.y), bfhi(b1.y)} * rs1 * w2; *(f32x4*)(xr + 516) = (f32x4){bflo(b1.z), bfhi(b1.z), bflo(b1.w), bfhi(b1.w)} * rs1 * w3; }
    }
}

__device__ __forceinline__ RsTab rs_table_build(LAS unsigned char* lds, const pg8::StaticOrder& S, const float* part) {
    RsTab t; t.tab = (const LAS float*)(lds + 131072); t.g0 = 0; t.ok = 0;
    pg8::Unit u; if (!S.next(0, u)) return t;
    const int k = u.pm & 7; int gmin = u.pm >> 3, gmax = gmin, good = 1;
    for (int i = 1; S.next(i, u); ++i) { const int gq = u.pm >> 3; gmin = gq < gmin ? gq : gmin; gmax = gq > gmax ? gq : gmax; good &= ((u.pm & 7) == k); }
    if (!good || gmax - gmin >= 8) return t;
    LAS float* w = (LAS float*)(lds + 131072);
    for (int i = threadIdx.x; i < (gmax - gmin + 1) * 256; i += 512) { const int row = (((gmin + (i >> 8)) << 3) + k) * 256 + (i & 255); w[i] = row_rs(part, row); }
    __syncthreads();
    t.g0 = gmin; t.ok = 1; return t;
}
constexpr int NPHASE = 10;
__global__ void __launch_bounds__(512, 2) hymba_fwd(Params p, int ph_lo, int ph_hi) {
    extern __shared__ __attribute__((aligned(16))) unsigned char lds_raw[];
    LAS unsigned char* lds = (LAS unsigned char*)lds_raw;
    const int tid = threadIdx.x, lane = tid & 63, wave = __builtin_amdgcn_readfirstlane(tid >> 6);
    const int G = gridDim.x, bx = blockIdx.x, gw = bx * 8 + wave, ngw = G * 8;
    unsigned char* ws = p.ws;
    float* rowss = (float*)(ws + WS_SMALL);
    bf16_t* XNB = (bf16_t*)(ws + WS_XNB); bf16_t* Hb = (bf16_t*)(ws + WS_H); bf16_t* X1B = (bf16_t*)p.out;
#if MK_LAUNCH_PER_PHASE
#define SEAM(k) do { } while (0)
#else
    cg::grid_group grid = cg::this_grid();
    if (tid < 8) ((LAS unsigned*)(lds + LDS_BYTES - 64))[tid] = 0u;
    __syncthreads();
    const XcdBarrier xbar = xcd_barrier_post((unsigned*)(ws + WS_BAR), (volatile LAS unsigned*)(lds + LDS_BYTES - 64));
    if (ph_lo < 0) grid.sync();
#define SEAM(k) do { if (ph_lo <= (k) && (k) + 1 < ph_hi) xcd_barrier(xbar); } while (0)
#endif
#ifdef ONLY
#define IN(k) ((k) == ONLY && ph_lo <= (k) && (k) < ph_hi)
#else
#define IN(k) (ph_lo <= (k) && (k) < ph_hi)
#endif
#ifdef TSA
    unsigned long long* TS = (unsigned long long*)(ws + WS_CHDEC + 65536);
#define STAMP(k) do { if (bx == 0 && tid == 0) TS[k] = __builtin_amdgcn_s_memrealtime(); } while (0)
#else
#define STAMP(k) do { } while (0)
#endif
    STAMP(0);
    if (IN(0)) { phase0(p, lds, gw, ngw, lane, wave); }
#if defined(DUP) && DUP == 0
    __syncthreads(); phase0(p, lds, gw, ngw, lane, wave);
#endif
    SEAM(0); STAMP(1);
    if (IN(1)) { pg8::Gemm g{XNB, (const bf16_t*)(ws + WS_WFA), T, 2 * FF, D}; pg8::StaticOrder S; S.init(T, 2 * FF, G, bx); EpiGateUp<false> E{Hb, nullptr, RsTab{nullptr, 0, 0}};
        pg8::gemm_phase<EpiGateUp<false>, pg8::StaticOrder, true, true>(lds, g, S, E);
        if (mix_weights_in_p1(G)) { const int heavy = ((T / 256) * (2 * FF / 256)) % G;
            if (bx >= heavy) { LAS float* scr = (LAS float*)(lds + wave * 16384);
                for (int it = (bx - heavy) * 8 + wave; it < MIX_W_ITEMS + 2816; it += (G - heavy) * 8) {
                    if (it < MIX_W_ITEMS) mix_weight_item(p, scr, it, lane);
                    else ffn_weight_item(p.in[19], p.in[20], p.in[21], p.in[18], (bf16_t*)(ws + WS_W2A), (bf16_t*)(ws + WS_W2D), scr, it - MIX_W_ITEMS, lane); } } }
#if defined(DUP) && DUP == 1
        pg8::gemm_phase<EpiGateUp<false>, pg8::StaticOrder, true, true>(lds, g, S, E);
#endif
    }
    SEAM(1); STAMP(2);
    if (IN(2)) { pg8::Gemm g{Hb, (const bf16_t*)(ws + WS_WFD), T, D, FF}; pg8::StaticOrder S; S.init(T, D, G, bx); EpiDown1 E{p.in[0], p.in[1], XNB, rowss};
        pg8::gemm_phase<EpiDown1, pg8::StaticOrder, true, true>(lds, g, S, E); }
    SEAM(2); STAMP(3);
    if (IN(3)) { pg8::Gemm g{XNB, (const bf16_t*)(ws + WS_WIN), T, 4096, D}; pg8::StaticOrder S; S.init(T, 4096, G, bx);
        EpiInProj E{(bf16_t*)(ws + WS_ZQ), (bf16_t*)(ws + WS_XBC), (bf16_t*)(ws + WS_KV), rowss, rs_table_build(lds, S, rowss), (bf16_t*)(ws + WS_HALO)};
        pg8::gemm_phase<EpiInProj, pg8::StaticOrder, true, true>(lds, g, S, E);
        dt_phase(p, XNB, gw, ngw, lane); }
    SEAM(3); STAMP(4);
    if (IN(4)) {
        int it = bx;
        for (; it < 768; it += G) ssd_states_item(p, lds, it >> 1, it & 1, (G & 1) || it == bx);
        STAMP(12);
        __syncthreads();
        if (it < 768 + 1536) {
            AttnPre pre; { const int a = it - 768; attn_issue(p, pre, tid, lane, wave, a / 256, (a >> 2) & 63, a & 3); }
            for (; it < 768 + 1536; it += G) { const int a = it - 768, an = a + G; const bool more = it + G < 768 + 1536;
                attn_item(p, lds, pre, a / 256, (a >> 2) & 63, a & 3, more ? an / 256 : -1, (an >> 2) & 63, an & 3); }
        }
    }
#if defined(DUP) && DUP == 4
    for (int it = bx; it < 768; it += G) ssd_states_item(p, lds, it >> 1, it & 1, true);
#endif
    STAMP(20);
    SEAM(4); STAMP(5);
    if (IN(5)) { ssd_scan_phase(p); }
    SEAM(5); STAMP(6);
    if (IN(6)) { for (int it = bx; it < 768; it += G) ssd_out_item(p, lds, it >> 1, it & 1); }
    SEAM(6); STAMP(7);
    if (IN(7)) {
        __syncthreads();
        if (!mix_weights_in_p1(G)) { LAS float* scr = (LAS float*)(lds + wave * 16384); for (int it = gw; it < FFN_W_ITEMS; it += ngw) ffn_weight_item(p.in[19], p.in[20], p.in[21], p.in[18], (bf16_t*)(ws + WS_W2A), (bf16_t*)(ws + WS_W2D), scr, it, lane); }
        __syncthreads();
        pg8::Gemm g{(const bf16_t*)(ws + WS_ZQ), (const bf16_t*)(ws + WS_WOUT), T, D, 2048}; pg8::StaticOrder S; S.init(T, D, G, bx); EpiOutProj E{XNB, rowss + (size_t)T * 16};
        pg8::gemm_phase<EpiOutProj, pg8::StaticOrder, true, true>(lds, g, S, E); }
    SEAM(7); STAMP(8);
    if (IN(8)) { pg8::Gemm g{XNB, (const bf16_t*)(ws + WS_W2A), T, 2 * FF, D}; pg8::StaticOrder S; S.init(T, 2 * FF, G, bx); EpiGateUp<true> E{Hb, rowss + (size_t)T * 16, rs_table_build(lds, S, rowss + (size_t)T * 16)};
        pg8::gemm_phase<EpiGateUp<true>, pg8::StaticOrder, true, true>(lds, g, S, E);
        if (mix_weights_in_p1(G)) { const int heavy = ((T / 256) * (2 * FF / 256)) % G;
            if (bx >= heavy) { LAS float* scr = (LAS float*)(lds + wave * 16384);
                for (int it = 2816 + (bx - heavy) * 8 + wave; it < FFN_W_ITEMS; it += (G - heavy) * 8)
                    ffn_weight_item(p.in[19], p.in[20], p.in[21], p.in[18], (bf16_t*)(ws + WS_W2A), (bf16_t*)(ws + WS_W2D), scr, it, lane); } } }
    SEAM(8); STAMP(9);
    if (IN(9)) { pg8::Gemm g{Hb, (const bf16_t*)(ws + WS_W2D), T, D, FF}; pg8::StaticOrder S; S.init(T, D, G, bx); EpiDown2 E{p.out, XNB, rowss + (size_t)2 * T * 16};
        pg8::gemm_phase<EpiDown2, pg8::StaticOrder, true, true>(lds, g, S, E); }
    SEAM(9); STAMP(10);
#if defined(TSA) && !MK_LAUNCH_PER_PHASE
    STAMP(21); xcd_barrier(xbar); STAMP(22); grid.sync(); STAMP(23);
#endif
    if (IN(10)) { final_norm_phase(p, gw, ngw, lane); }
#ifdef TSA
    if (bx == 0 && tid == 0) { TS[11] = __builtin_amdgcn_s_memrealtime();
        const float ua = (float)(TS[TSA1] - TS[TSA]) * 0.01f, ub = (float)(TS[TSB1] - TS[TSB]) * 0.01f;
        p.out[1] += ua * TSSCALE; p.out[2] += ub * TSSCALE; }
#endif
#undef IN
#undef SEAM
}


#ifdef DBG_STOP
__global__ void dbg_dump(Params p, int mode) {
    const bf16_t* ZQ = (const bf16_t*)(p.ws + WS_ZQ); const bf16_t* XBC = (const bf16_t*)(p.ws + WS_XBC); const bf16_t* KV = (const bf16_t*)(p.ws + WS_KV); const float* DT = (const float*)(p.ws + WS_DT);
    const bf16_t* Hb = (const bf16_t*)(p.ws + WS_H); const bf16_t* XNB = (const bf16_t*)(p.ws + WS_XNB);
    for (size_t i = (size_t)blockIdx.x * blockDim.x + threadIdx.x; i < (size_t)T * D; i += (size_t)gridDim.x * blockDim.x) {
        float v = 0.f;
        if (mode == 1) { v = bflo(Hb[i]) + bflo(Hb[i + (size_t)T * D]) + bflo(Hb[(i + (size_t)2 * T * D) % ((size_t)T * FF)]); }
        else if (mode == 2) { v = bflo(XNB[i]); }
        else if (mode == 3 || mode == 4 || mode == 6) { v = bflo(ZQ[2 * i]) + bflo(ZQ[2 * i + 1]) + bflo(XBC[i]) + bflo(XBC[i + (size_t)T * 512]) + bflo(KV[i % ((size_t)T * 512)]) + DT[i % ((size_t)T * 32)]; }
        if (mode == 2 || mode == 4 || mode == 5) { const unsigned w = ((const unsigned*)p.out)[i]; v += bflo(w) + bfhi(w); }
        if (!(fabsf(v) < 1e30f)) v = 777.f;
        p.out[i] = v;
    }
}
#endif
extern "C" void kernel_launch(void* const* d_in, const int* in_sizes, int n_in, void* d_out, int out_size, void* d_ws, size_t ws_size, hipStream_t stream) {
    static int grid = 0;
    if (grid == 0) {
        if (n_in != 23 || out_size != T * D || ws_size < WS_END) { fprintf(stderr, "kernel_launch: unexpected shapes: n_in %d out %d ws %zu (need %zu)\n", n_in, out_size, ws_size, (size_t)WS_END); grid = -1; return; }
        int dev = 0, cus = 0, per_cu = 0;
        hipGetDevice(&dev); hipDeviceGetAttribute(&cus, hipDeviceAttributeMultiprocessorCount, dev);
        if (hipFuncSetAttribute((const void*)hymba_fwd, hipFuncAttributeMaxDynamicSharedMemorySize, LDS_BYTES) != hipSuccess) { fprintf(stderr, "kernel_launch: hipFuncSetAttribute failed\n"); grid = -1; return; }
        if (hipOccupancyMaxActiveBlocksPerMultiprocessor(&per_cu, (const void*)hymba_fwd, 512, LDS_BYTES) != hipSuccess || per_cu < 1) { fprintf(stderr, "kernel_launch: occupancy query says %d\n", per_cu); per_cu = 1; }
        (void)hipGetLastError();
        grid = cus;
    }
    if (grid < 0) return;
    Params p{};
    for (int i = 0; i < 23; ++i) p.in[i] = (const float*)d_in[i];
    p.out = (float*)d_out; p.ws = (unsigned char*)d_ws;
#if MK_LAUNCH_PER_PHASE
#ifdef DBG_STOP
    for (int k = 0; k <= DBG_STOP; ++k) hipLaunchKernelGGL(hymba_fwd, dim3(grid), dim3(512), LDS_BYTES, stream, p, k, k + 1);
    hipLaunchKernelGGL(dbg_dump, dim3(2048), dim3(256), 0, stream, p, DBG_STOP);
#else
    for (int k = 0; k <= NPHASE; ++k) hipLaunchKernelGGL(hymba_fwd, dim3(grid), dim3(512), LDS_BYTES, stream, p, k, k + 1);
#endif
#else
    if (hipMemsetAsync((char*)d_ws + WS_BAR, 0, XCD_BAR_WORDS * 4, stream) != hipSuccess) { fprintf(stderr, "kernel_launch: memset failed\n"); return; }
    int lo = 0, hi = NPHASE + 1;
    void* args[] = {&p, &lo, &hi};
    hipError_t e = hipLaunchCooperativeKernel((const void*)hymba_fwd, dim3(grid), dim3(512), args, LDS_BYTES, stream);
    if (e != hipSuccess) fprintf(stderr, "kernel_launch: cooperative launch failed: %s (grid %d)\n", hipGetErrorString(e), grid);
#endif
}
```

```cpp
#include <hip/hip_runtime.h>
#include <hip/hip_cooperative_groups.h>
#include <cstdio>
#include <cstdint>
namespace cg = cooperative_groups;
namespace pg8 {
#define PG8_LAS __attribute__((address_space(3)))
typedef unsigned short bf16_t;
typedef short bf16x8 __attribute__((ext_vector_type(8)));
typedef float f32x4 __attribute__((ext_vector_type(4)));
typedef unsigned u32x4 __attribute__((ext_vector_type(4)));
constexpr int BM = 256, BK = 64, HALF = 128, HTB = HALF * BK * 2  , STAGE_BYTES = 8 * HTB, NXCD = 8, WGM = 8;

__host__ __device__ __forceinline__ int lds_byte(int r, int c) { const int st = (r >> 4) * 2 + (c >> 5), rr = r & 15, cc = c & 31, ob = rr * 64 + cc * 2; return st * 1024 + (ob ^ (((ob >> 9) & 1) << 5)); }
__host__ __device__ __forceinline__ void stage_rc(int b, int& R, int& C) { const int st = b / 1024, sb = b % 1024, swz = sb ^ (((sb >> 9) & 1) << 5); R = (st >> 1) * 16 + swz / 64; C = (st & 1) * 32 + (swz % 64) / 2; }
__host__ __device__ __forceinline__ int perm32(int rho) { const int n = rho >> 4, i = rho & 15; return 8 * (i >> 2) + 4 * n + (i & 3); }

struct Unit { int pm, pn; };
struct Gemm { const bf16_t* A; const bf16_t* Bt; int M, N, K; };

struct StaticOrder {
    int nM, nN, nwg, G, c;
    __host__ __device__ void init(int M, int N, int G_, int c_) { nM = M / BM; nN = N / BM; nwg = nM * nN; G = G_; c = c_; }
    __host__ __device__ bool next(int i, Unit& u) const {
        const long L = (long)i * G + c; if (L >= nwg) return false;
        int wgid = (int)L; { const int q = nwg / NXCD, r = nwg % NXCD, xcd = wgid % NXCD, off = wgid / NXCD; wgid = (xcd < r ? xcd * (q + 1) : r * (q + 1) + (xcd - r) * q) + off; }
        const int nig = WGM * nN, gid = wgid / nig, fm = gid * WGM, gsz = (nM - fm) < WGM ? (nM - fm) : WGM;
        u.pm = fm + ((wgid % nig) % gsz); u.pn = (wgid % nig) / gsz; return true;
    }
    __device__ __forceinline__ void a_ready(const Unit&) const {}
    __device__ __forceinline__ void done(const Unit&) const {}
};

__device__ __forceinline__ unsigned cvt_pk_bf16(float lo, float hi) { unsigned r; asm volatile("v_cvt_pk_bf16_f32 %0, %1, %2" : "=v"(r) : "v"(lo), "v"(hi)); return r; }
template <class Epi, class Sched, bool ALIGN_EPI = false, bool SP2 = false>
__device__ __forceinline__ void gemm_phase(PG8_LAS unsigned char* lds, const Gemm g, const Sched& S, const Epi& E) {
    const int tid = threadIdx.x, wid = __builtin_amdgcn_readfirstlane(tid >> 6), lane = tid & 63, wr = wid >> 2, wc = wid & 3, fr = lane & 15, fq = lane >> 4;
    const int K = g.K, nt = K / BK;
    unsigned voffA[2], voffB[2];
#pragma unroll
    for (int i = 0; i < 2; ++i) { int R, C; stage_rc(tid * 16 + i * 8192, R, C); const int Rb = Epi::PERM ? ((R & ~31) + perm32(R & 31)) : R;
        voffA[i] = (unsigned)(R * K + C) * 2u; voffB[i] = (unsigned)(Rb * K + C) * 2u; }
    const size_t kstep = (size_t)(BK * 2);
    const size_t hstep = (size_t)HALF * K * 2;
    const size_t tstep = 2 * hstep;
    const unsigned ldsw = (unsigned)wid * 1024u;
    const int aoff = lds_byte(wr * 64 + fr, fq * 8), boff = lds_byte(wc * 32 + fr, fq * 8);
#define PG8_SA(b, h) (((b) * 2 + (h)) * HTB)
#define PG8_SB(b, h) ((4 + (b) * 2 + (h)) * HTB)
#define PG8_STAGE(bufoff, gbase, voff) do { _Pragma("unroll") for (int _i = 0; _i < 2; ++_i) \
        __builtin_amdgcn_global_load_lds((const unsigned*)((const char*)(gbase) + (voff)[_i]), (PG8_LAS unsigned*)(lds + (bufoff) + ldsw + _i * 8192), 16, 0, 0); } while (0)
#define PG8_LDA(dst, b, h) do { _Pragma("unroll") for (int m = 0; m < 4; ++m) _Pragma("unroll") for (int k = 0; k < 2; ++k) dst[m][k] = *(const PG8_LAS bf16x8*)(lds + PG8_SA(b, h) + aoff + m * 2048 + k * 1024); } while (0)
#define PG8_LDB(dst, b, h) do { _Pragma("unroll") for (int n = 0; n < 2; ++n) _Pragma("unroll") for (int k = 0; k < 2; ++k) dst[n][k] = *(const PG8_LAS bf16x8*)(lds + PG8_SB(b, h) + boff + n * 2048 + k * 1024); } while (0)
#define PG8_MMA(ai, bj, At, Bt) do { __builtin_amdgcn_s_setprio(1); _Pragma("unroll") for (int m = 0; m < 4; ++m) _Pragma("unroll") for (int n = 0; n < 2; ++n) _Pragma("unroll") for (int k = 0; k < 2; ++k) \
        acc[ai][bj][m][n] = __builtin_amdgcn_mfma_f32_16x16x32_bf16(Bt[n][k], At[m][k], acc[ai][bj][m][n], 0, 0, 0); __builtin_amdgcn_s_setprio(0); } while (0)
#define PG8_WAIT_V(n) asm volatile("s_waitcnt vmcnt(" #n ")" ::: "memory")
#define PG8_WAIT_L(n) asm volatile("s_waitcnt lgkmcnt(" #n ")" ::: "memory")
#define PG8_BAR __builtin_amdgcn_s_barrier()
#define PG8_SCHED __builtin_amdgcn_sched_barrier(0)
    Unit cur, nxt; int ui = 0;
    if (!S.next(0, cur)) return;
    f32x4 acc[2][2][4][2];
#pragma unroll
    for (int a = 0; a < 2; ++a)
#pragma unroll
        for (int b = 0; b < 2; ++b)
#pragma unroll
            for (int m = 0; m < 4; ++m)
#pragma unroll
                for (int n = 0; n < 2; ++n) acc[a][b][m][n] = (f32x4){0.f, 0.f, 0.f, 0.f};
    bf16x8 At[4][2], B0[2][2], B1[2][2];
    const char* cA = (const char*)g.A + (size_t)cur.pm * tstep; const char* cB = (const char*)g.Bt + (size_t)cur.pn * tstep;
    S.a_ready(cur);
    if constexpr (SP2) {
        PG8_STAGE(PG8_SB(0, 0), cB, voffB); PG8_STAGE(PG8_SB(0, 1), cB + hstep, voffB); PG8_STAGE(PG8_SA(0, 0), cA, voffA); PG8_STAGE(PG8_SA(0, 1), cA + hstep, voffA);
        if (wr == 1) PG8_BAR;
        PG8_WAIT_V(2); PG8_BAR;
        PG8_STAGE(PG8_SB(1, 0), cB + kstep, voffB); PG8_STAGE(PG8_SA(1, 0), cA + kstep, voffA); PG8_STAGE(PG8_SB(1, 1), cB + hstep + kstep, voffB);
        PG8_WAIT_V(6); PG8_BAR;
    } else {
        PG8_STAGE(PG8_SB(0, 0), cB, voffB); PG8_STAGE(PG8_SA(0, 0), cA, voffA); PG8_STAGE(PG8_SB(0, 1), cB + hstep, voffB); PG8_STAGE(PG8_SA(0, 1), cA + hstep, voffA);
        if (wr == 1) PG8_BAR;
        PG8_WAIT_V(4); PG8_BAR;
        PG8_STAGE(PG8_SB(1, 0), cB + kstep, voffB); PG8_STAGE(PG8_SA(1, 0), cA + kstep, voffA); PG8_STAGE(PG8_SB(1, 1), cB + hstep + kstep, voffB);
        PG8_WAIT_V(6); PG8_BAR;
    }
    for (;;) {
        const bool has_next = S.next(ui + 1, nxt);
        const char* nA = has_next ? (const char*)g.A + (size_t)nxt.pm * tstep : cA; const char* nB = has_next ? (const char*)g.Bt + (size_t)nxt.pn * tstep : cB;
        for (int t = 0; t < nt; t += 2) {
            const bool last = (t == nt - 2);
            const char* a1 = cA + (size_t)(t + 1) * kstep;
            const char* a2 = last ? nA : cA + (size_t)(t + 2) * kstep; const char* b2 = last ? nB : cB + (size_t)(t + 2) * kstep;
            const char* a3 = a2 + kstep; const char* b3 = b2 + kstep;
            if (last && has_next) S.a_ready(nxt);
            if constexpr (SP2) {
            PG8_LDB(B0, 0, 0); PG8_LDB(B1, 0, 1); PG8_SCHED; PG8_LDA(At, 0, 0); PG8_STAGE(PG8_SA(1, 1), a1 + hstep, voffA);
            PG8_WAIT_V(8); PG8_WAIT_L(0); PG8_BAR; PG8_MMA(0, 0, At, B0); PG8_MMA(0, 1, At, B1); PG8_BAR; PG8_SCHED;
            PG8_LDA(At, 0, 1); PG8_STAGE(PG8_SB(0, 0), b2, voffB); PG8_STAGE(PG8_SB(0, 1), b2 + hstep, voffB); PG8_STAGE(PG8_SA(0, 0), a2, voffA);
            PG8_WAIT_V(8); PG8_WAIT_L(0); PG8_BAR; PG8_MMA(1, 0, At, B0); PG8_MMA(1, 1, At, B1); PG8_BAR; PG8_SCHED;
            PG8_LDB(B0, 1, 0); PG8_LDB(B1, 1, 1); PG8_SCHED; PG8_LDA(At, 1, 0); PG8_STAGE(PG8_SA(0, 1), a2 + hstep, voffA);
            PG8_WAIT_V(8); PG8_WAIT_L(0); PG8_BAR; PG8_MMA(0, 0, At, B0); PG8_MMA(0, 1, At, B1); PG8_BAR; PG8_SCHED;
            PG8_LDA(At, 1, 1); PG8_STAGE(PG8_SB(1, 0), b3, voffB); PG8_STAGE(PG8_SB(1, 1), b3 + hstep, voffB); PG8_STAGE(PG8_SA(1, 0), a3, voffA);
            PG8_WAIT_V(8); PG8_WAIT_L(0); PG8_BAR; PG8_MMA(1, 0, At, B0); PG8_MMA(1, 1, At, B1); PG8_BAR; PG8_SCHED;
            } else {
            PG8_LDB(B0, 0, 0); PG8_SCHED; PG8_LDA(At, 0, 0); PG8_STAGE(PG8_SA(1, 1), a1 + hstep, voffA);
            PG8_WAIT_L(8); PG8_BAR; PG8_WAIT_L(0); PG8_MMA(0, 0, At, B0); PG8_BAR; PG8_SCHED;
            PG8_LDB(B1, 0, 1); PG8_STAGE(PG8_SB(0, 0), b2, voffB);
            PG8_BAR; PG8_WAIT_L(0); PG8_MMA(0, 1, At, B1); PG8_BAR;
            PG8_LDA(At, 0, 1); PG8_STAGE(PG8_SA(0, 0), a2, voffA);
            PG8_BAR; PG8_WAIT_L(0); PG8_MMA(1, 0, At, B0); PG8_BAR; PG8_SCHED;
            PG8_STAGE(PG8_SB(0, 1), b2 + hstep, voffB);
            PG8_WAIT_V(6); PG8_BAR; PG8_MMA(1, 1, At, B1); PG8_BAR;
            PG8_LDB(B0, 1, 0); PG8_SCHED; PG8_LDA(At, 1, 0); PG8_STAGE(PG8_SA(0, 1), a2 + hstep, voffA);
            PG8_WAIT_L(8); PG8_BAR; PG8_WAIT_L(0); PG8_MMA(0, 0, At, B0); PG8_BAR; PG8_SCHED;
            PG8_LDB(B1, 1, 1); PG8_STAGE(PG8_SB(1, 0), b3, voffB);
            PG8_BAR; PG8_WAIT_L(0); PG8_MMA(0, 1, At, B1); PG8_BAR;
            PG8_LDA(At, 1, 1); PG8_STAGE(PG8_SA(1, 0), a3, voffA);
            PG8_BAR; PG8_WAIT_L(0); PG8_MMA(1, 0, At, B0); PG8_BAR; PG8_SCHED;
            PG8_STAGE(PG8_SB(1, 1), b3 + hstep, voffB);
            PG8_WAIT_V(6); PG8_BAR; PG8_MMA(1, 1, At, B1); PG8_BAR;
            }
        }
        if constexpr (ALIGN_EPI) { if (wr == 0) PG8_BAR; }
        if constexpr (!Epi::AFTER_DRAIN) { E(acc, cur, wr, wc, fr, fq); S.done(cur); }
        if (!has_next) break;
#pragma unroll
        for (int a = 0; a < 2; ++a)
#pragma unroll
            for (int b = 0; b < 2; ++b)
#pragma unroll
                for (int m = 0; m < 4; ++m)
#pragma unroll
                    for (int n = 0; n < 2; ++n) acc[a][b][m][n] = (f32x4){0.f, 0.f, 0.f, 0.f};
        cur = nxt; cA = nA; cB = nB; ++ui;
        if constexpr (ALIGN_EPI) { if (wr == 1) PG8_BAR; }
    }
    PG8_WAIT_V(0);
    if constexpr (!ALIGN_EPI) { if (wr == 0) PG8_BAR; }
    PG8_BAR;
    if constexpr (Epi::AFTER_DRAIN) { E.fused(acc, cur, wr, wc, fr, fq, lds, wid, lane); S.done(cur); }
#undef PG8_SA
#undef PG8_SB
#undef PG8_STAGE
#undef PG8_LDA
#undef PG8_LDB
#undef PG8_MMA
#undef PG8_WAIT_V
#undef PG8_WAIT_L
#undef PG8_BAR
#undef PG8_SCHED
}
}

using pg8::bf16_t; using pg8::bf16x8; using pg8::f32x4; using pg8::u32x4;
typedef __bf16 bf16v2_t __attribute__((ext_vector_type(2)));
typedef float f32v2_t __attribute__((ext_vector_type(2)));
__device__ __forceinline__ unsigned cvt_pk_bf16(float lo, float hi) { const f32v2_t v = {lo, hi}; const bf16v2_t b = __builtin_convertvector(v, bf16v2_t); return __builtin_bit_cast(unsigned, b); }
#define LAS __attribute__((address_space(3)))
typedef unsigned u32x2 __attribute__((ext_vector_type(2)));

#ifndef MK_LAUNCH_PER_PHASE
#define MK_LAUNCH_PER_PHASE 0
#endif

constexpr int T = 49152, D = 1024, FF = 2816, SEQL = 8192, TP = 32768, NCHUNK = 384;
constexpr float EPS = 1e-6f;
constexpr float LOG2E = 1.44269504088896f;
constexpr size_t MiB = 1u << 20;
constexpr size_t WS_ZQ = 0;
constexpr size_t WS_XBC = 192 * MiB;
constexpr size_t WS_KV = 336 * MiB;
constexpr size_t WS_DT = 384 * MiB;
constexpr size_t WS_XNB = 390 * MiB;
constexpr size_t WS_WIN = 486 * MiB;
constexpr size_t WS_WOUT = 495 * MiB;
constexpr size_t WS_SMALL = 499 * MiB;
constexpr size_t WS_HALO = 505 * MiB;
constexpr size_t WS_CHDEC = 509 * MiB;
constexpr size_t WS_BAR = 510 * MiB;
constexpr size_t WS_W2A = 512 * MiB;
constexpr size_t WS_W2D = 523 * MiB;
constexpr size_t WS_END = 529 * MiB;
constexpr size_t WS_H = 0;
constexpr size_t WS_WFA = 264 * MiB;
constexpr size_t WS_WFD = 275 * MiB;
constexpr int LDS_BYTES = 147456;

#define XB_TMO      128
#define XB_XCNT(j)  (256  + 64 * (j))
#define XB_XSUB(j)  (1280 + 64 * (j))
#define XB_XGEN(j)  (2304 + 64 * (j))
#define XB_TOP      3328
#define XB_TOPGEN   3392
#define XCD_BAR_WORDS 3456
#define XB_SPIN_CAP (1u << 18)

__device__ __forceinline__ unsigned xb_ld(unsigned* p)              { return __hip_atomic_load(p, __ATOMIC_RELAXED, __HIP_MEMORY_SCOPE_AGENT); }
__device__ __forceinline__ unsigned xb_add(unsigned* p, unsigned v) { return __hip_atomic_fetch_add(p, v, __ATOMIC_RELAXED, __HIP_MEMORY_SCOPE_AGENT); }
__device__ __forceinline__ unsigned xb_xcc_id() { return (unsigned)__builtin_amdgcn_s_getreg((3 << 11) | 20) & 0xFu; }
#define XB_SPIN(cond, bar) do { unsigned _sp = 0; while (cond) { __builtin_amdgcn_s_sleep(1); \
    if ((++_sp & 255u) == 0u) { if (xb_ld(&(bar)[XB_TMO])) break; if (_sp > XB_SPIN_CAP) { atomicAdd(&(bar)[XB_TMO], 1u); break; } } } } while (0)

struct XcdBarrier {
    unsigned* bar; unsigned x;
    volatile LAS unsigned* st;
};

__device__ __forceinline__ XcdBarrier xcd_barrier_post(unsigned* bar, volatile LAS unsigned* st) {
    XcdBarrier b; b.bar = bar; b.x = xb_xcc_id(); b.st = st;
    if (threadIdx.x == 0) (void)xb_add(&bar[XB_XCNT(b.x)], 1u);
    return b;
}
__device__ __forceinline__ void xcd_barrier_complete(unsigned* bar, unsigned x, unsigned& nloc, unsigned& nx) {
    const unsigned G = gridDim.x * gridDim.y * gridDim.z;
    unsigned sum, cnt, mine, sp = 0u;
    for (;;) {
        sum = 0u; cnt = 0u; mine = 0u;
#pragma unroll
        for (unsigned j = 0; j < 16; ++j) { const unsigned c = xb_ld(&bar[XB_XCNT(j)]); sum += c; cnt += (c > 0u) ? 1u : 0u; mine = (j == x) ? c : mine; }
        if (sum == G) break;
        __builtin_amdgcn_s_sleep(1);
        if ((++sp & 255u) == 0u) { if (xb_ld(&bar[XB_TMO])) break; if (sp > XB_SPIN_CAP) { atomicAdd(&bar[XB_TMO], 1u); break; } }
    }
    nloc = mine > 0u ? mine : 1u; nx = cnt > 0u ? cnt : 1u;
}

__device__ __forceinline__ void xcd_barrier(const XcdBarrier& b) {
    asm volatile("s_waitcnt vmcnt(0)" ::: "memory");
    __syncthreads();
    if (threadIdx.x == 0) {
        unsigned* bar = b.bar;
        __builtin_amdgcn_s_waitcnt(0);
        unsigned nloc = b.st[0], nx = b.st[1];
        if (nloc == 0u) { xcd_barrier_complete(bar, b.x, nloc, nx); b.st[0] = nloc; b.st[1] = nx; }
        const unsigned old = xb_add(&bar[XB_XSUB(b.x)], 1u);
        const unsigned gen = old / nloc;
        if (old + 1u == (gen + 1u) * nloc) {
            __builtin_amdgcn_fence(__ATOMIC_RELEASE, "agent");
            asm volatile("s_waitcnt vmcnt(0)" ::: "memory");
            const unsigned og = xb_add(&bar[XB_TOP], 1u);
            const unsigned tg = og / nx;
            if (og + 1u == (tg + 1u) * nx) xb_add(&bar[XB_TOPGEN], 1u);
            else XB_SPIN(xb_ld(&bar[XB_TOPGEN]) == tg, bar);
            __builtin_amdgcn_fence(__ATOMIC_ACQUIRE, "agent");
            xb_add(&bar[XB_XGEN(b.x)], 1u);
            asm volatile("s_waitcnt vmcnt(0)" ::: "memory");
        } else {
            XB_SPIN(xb_ld(&bar[XB_XGEN(b.x)]) == gen, bar);
            __builtin_amdgcn_fence(__ATOMIC_ACQUIRE, "agent");
            asm volatile("s_waitcnt vmcnt(0)" ::: "memory");
        }
    }
    __syncthreads();
}

struct Params { const float* in[23]; float* out; unsigned char* ws; };
#ifdef TSA
#define ISTAMP(cond, k) do { if ((cond) && blockIdx.x == 0 && threadIdx.x == 0) ((unsigned long long*)(p.ws + WS_CHDEC + 65536))[k] = __builtin_amdgcn_s_memrealtime(); } while (0)
#else
#define ISTAMP(cond, k) do { } while (0)
#endif
#ifndef TSSCALE
#define TSSCALE 0.02f
#endif

__device__ __forceinline__ float bflo(unsigned w) { return __uint_as_float(w << 16); }
__device__ __forceinline__ float bfhi(unsigned w) { return __uint_as_float(w & 0xffff0000u); }
__device__ __forceinline__ float silu_f(float v) { return v * __builtin_amdgcn_rcpf(1.f + __expf(-v)); }
__device__ __forceinline__ float wave_sum(float v) {
#pragma unroll
    for (int o = 1; o < 64; o <<= 1) v += __shfl_xor(v, o);
    return v;
}
__device__ __forceinline__ float row_rs(const float* part, int row) {
    const f32x4* q = (const f32x4*)(part + (size_t)row * 16); const f32x4 a = q[0], b = q[1], c = q[2], d = q[3];
    const float s = (((a[0] + a[1]) + (a[2] + a[3])) + ((b[0] + b[1]) + (b[2] + b[3]))) + (((c[0] + c[1]) + (c[2] + c[3])) + ((d[0] + d[1]) + (d[2] + d[3])));
    return rsqrtf(s * (1.f / D) + EPS);
}
__device__ __forceinline__ float row_rs_q(const float* part, int row, int fq) {
    const f32x4 a = ((const f32x4*)(part + (size_t)row * 16))[fq]; float s = (a[0] + a[1]) + (a[2] + a[3]);
    s += __shfl_xor(s, 16); s += __shfl_xor(s, 32);
    return rsqrtf(s * (1.f / D) + EPS);
}
__device__ __forceinline__ u32x4 pk8(const f32x4 a, const f32x4 b) { u32x4 w; w.x = cvt_pk_bf16(a[0], a[1]); w.y = cvt_pk_bf16(a[2], a[3]); w.z = cvt_pk_bf16(b[0], b[1]); w.w = cvt_pk_bf16(b[2], b[3]); return w; }
__device__ __forceinline__ u32x2 pk4(const f32x4 a) { u32x2 w; w.x = cvt_pk_bf16(a[0], a[1]); w.y = cvt_pk_bf16(a[2], a[3]); return w; }
__device__ __forceinline__ f32x4 mfma16(const bf16x8 a, const bf16x8 b, const f32x4 c) { return __builtin_amdgcn_mfma_f32_16x16x32_bf16(a, b, c, 0, 0, 0); }

struct RsTab { const LAS float* tab; int g0; int ok; };
__device__ __forceinline__ float rs_lookup(const RsTab& t, const float* rowss, int pm, int row, int fq) { return t.ok ? t.tab[((pm >> 3) - t.g0) * 256 + (row & 255)] : row_rs_q(rowss, row, fq); }
template <bool HAS_RS> struct EpiGateUp {
    static constexpr bool PERM = true, AFTER_DRAIN = false;
    bf16_t* H; const float* rowss; RsTab rt;
    __device__ __forceinline__ void operator()(const f32x4 (&acc)[2][2][4][2], const pg8::Unit& u, int wr, int wc, int fr, int fq) const {
        const int row0 = u.pm * 256 + wr * 64 + fr, col0 = u.pn * 128 + wc * 32 + 8 * fq;
#pragma unroll
        for (int ai = 0; ai < 2; ++ai)
#pragma unroll
            for (int m = 0; m < 4; ++m) {
                const int row = row0 + ai * 128 + m * 16;
                f32x4 h0, h1;
                if constexpr (HAS_RS) { const float rs = rs_lookup(rt, rowss, u.pm, row, fq);
#pragma unroll
                    for (int j = 0; j < 4; ++j) { h0[j] = silu_f(acc[ai][0][m][0][j] * rs) * (acc[ai][1][m][0][j] * rs); h1[j] = silu_f(acc[ai][0][m][1][j] * rs) * (acc[ai][1][m][1][j] * rs); } }
                else {
#pragma unroll
                    for (int j = 0; j < 4; ++j) { h0[j] = silu_f(acc[ai][0][m][0][j]) * acc[ai][1][m][0][j]; h1[j] = silu_f(acc[ai][0][m][1][j]) * acc[ai][1][m][1][j]; } }
                *(u32x4*)(H + (size_t)row * FF + col0) = pk8(h0, h1);
            }
    }
};
struct EpiDown1 {
    static constexpr bool PERM = true, AFTER_DRAIN = false;
    const float* xp; const float* xs; bf16_t* x1b; float* rowss;
    __device__ __forceinline__ void operator()(const f32x4 (&acc)[2][2][4][2], const pg8::Unit& u, int wr, int wc, int fr, int fq) const {
        const int row0 = u.pm * 256 + wr * 64 + fr, col0 = u.pn * 256 + wc * 32 + 8 * fq;
#pragma unroll
        for (int ai = 0; ai < 2; ++ai)
#pragma unroll
            for (int mp = 0; mp < 2; ++mp) {
                f32x4 xv[2][2][2];
#pragma unroll
                for (int mm = 0; mm < 2; ++mm) { const int row = row0 + ai * 128 + (2 * mp + mm) * 16;
                    const float* xr = (row < TP ? xp + (size_t)row * D : xs + (size_t)(row - TP) * D) + col0;
#pragma unroll
                    for (int bj = 0; bj < 2; ++bj) { xv[mm][bj][0] = __builtin_nontemporal_load((const f32x4*)(xr + bj * 128)); xv[mm][bj][1] = __builtin_nontemporal_load((const f32x4*)(xr + bj * 128 + 4)); } }
#pragma unroll
                for (int mm = 0; mm < 2; ++mm) { const int m = 2 * mp + mm, row = row0 + ai * 128 + m * 16; const size_t o = (size_t)row * D + col0; float ss = 0.f;
#pragma unroll
                    for (int bj = 0; bj < 2; ++bj) {
                        const f32x4 d0 = acc[ai][bj][m][0] * 0.5f, d1 = acc[ai][bj][m][1] * 0.5f, y0 = xv[mm][bj][0] + d0, y1 = xv[mm][bj][1] + d1;
#pragma unroll
                        for (int j = 0; j < 4; ++j) ss += y0[j] * y0[j] + y1[j] * y1[j];
                        *(u32x4*)(x1b + o + bj * 128) = pk8(y0, y1); }
                    ss += __shfl_xor(ss, 16); ss += __shfl_xor(ss, 32);
                    if (fq == 0) rowss[(size_t)row * 16 + u.pn * 4 + wc] = ss; }
            }
    }
};
struct EpiInProj {
    static constexpr bool PERM = true, AFTER_DRAIN = false;
    bf16_t* zq; bf16_t* xbc; bf16_t* kv; const float* rowss; RsTab rt; bf16_t* halo;
    __device__ __forceinline__ void operator()(const f32x4 (&acc)[2][2][4][2], const pg8::Unit& u, int wr, int wc, int fr, int fq) const {
        const int row0 = u.pm * 256 + wr * 64 + fr, pn = u.pn;
        bf16_t* base; int pitch, cb;
        if (pn < 4) { base = zq; pitch = 2048; cb = pn * 256; } else if (pn < 10) { base = xbc; pitch = 1536; cb = (pn - 4) * 256; }
        else if (pn < 14) { base = zq; pitch = 2048; cb = 1024 + (pn - 10) * 256; } else { base = kv; pitch = 512; cb = (pn - 14) * 256; }
        const int col0 = cb + wc * 32 + 8 * fq;
#pragma unroll
        for (int ai = 0; ai < 2; ++ai)
#pragma unroll
            for (int m = 0; m < 4; ++m) {
                const int row = row0 + ai * 128 + m * 16;
                const float rs = rs_lookup(rt, rowss, u.pm, row, fq);
#pragma unroll
                for (int bj = 0; bj < 2; ++bj) { const u32x4 w = pk8(acc[ai][bj][m][0] * rs, acc[ai][bj][m][1] * rs);
                    *(u32x4*)(base + (size_t)row * pitch + col0 + bj * 128) = w;
                    if (pn >= 4 && pn < 8) { const int rl = row & 127; if (rl < 2 || rl >= 126) *(u32x4*)(halo + ((size_t)(row >> 7) * 4 + (rl < 2 ? rl : rl - 124)) * 1024 + col0 + bj * 128) = w; } }
            }
    }
};
struct EpiOutProj {
    static constexpr bool PERM = true, AFTER_DRAIN = false;
    bf16_t* dx; float* rowss;
    __device__ __forceinline__ void operator()(const f32x4 (&acc)[2][2][4][2], const pg8::Unit& u, int wr, int wc, int fr, int fq) const {
        const int row0 = u.pm * 256 + wr * 64 + fr, col0 = u.pn * 256 + wc * 32 + 8 * fq;
#pragma unroll
        for (int ai = 0; ai < 2; ++ai)
#pragma unroll
            for (int mp = 0; mp < 2; ++mp) {
                u32x4 dv[2][2];
#pragma unroll
                for (int mm = 0; mm < 2; ++mm) { const size_t o = (size_t)(row0 + ai * 128 + (2 * mp + mm) * 16) * D + col0;
#pragma unroll
                    for (int bj = 0; bj < 2; ++bj) dv[mm][bj] = *(const u32x4*)(dx + o + bj * 128); }
#pragma unroll
                for (int mm = 0; mm < 2; ++mm) { const int m = 2 * mp + mm, row = row0 + ai * 128 + m * 16; const size_t o = (size_t)row * D + col0; float ss = 0.f;
#pragma unroll
                    for (int bj = 0; bj < 2; ++bj) { const u32x4 dd = dv[mm][bj];
                        const f32x4 da = {bflo(dd.x), bfhi(dd.x), bflo(dd.y), bfhi(dd.y)}, db = {bflo(dd.z), bfhi(dd.z), bflo(dd.w), bfhi(dd.w)};
                        const f32x4 y0 = da + acc[ai][bj][m][0], y1 = db + acc[ai][bj][m][1];
#pragma unroll
                        for (int j = 0; j < 4; ++j) ss += y0[j] * y0[j] + y1[j] * y1[j];
                        *(u32x4*)(dx + o + bj * 128) = pk8(y0, y1); }
                    ss += __shfl_xor(ss, 16); ss += __shfl_xor(ss, 32);
                    if (fq == 0) rowss[(size_t)row * 16 + u.pn * 4 + wc] = ss; }
            }
    }
};
struct EpiDown2 {
    static constexpr bool PERM = true, AFTER_DRAIN = false;
    const float* out; bf16_t* x3b; float* rowss;
    __device__ __forceinline__ void operator()(const f32x4 (&acc)[2][2][4][2], const pg8::Unit& u, int wr, int wc, int fr, int fq) const {
        const int row0 = u.pm * 256 + wr * 64 + fr, col0 = u.pn * 256 + wc * 32 + 8 * fq;
#pragma unroll
        for (int ai = 0; ai < 2; ++ai)
#pragma unroll
            for (int mp = 0; mp < 2; ++mp) {
                f32x4 xv[2][2][2];
#pragma unroll
                for (int mm = 0; mm < 2; ++mm) { const size_t o = (size_t)(row0 + ai * 128 + (2 * mp + mm) * 16) * D + col0;
#pragma unroll
                    for (int bj = 0; bj < 2; ++bj) { const u32x4 dd = *(const u32x4*)(x3b + o + bj * 128);
                        xv[mm][bj][0] = (f32x4){bflo(dd.x), bfhi(dd.x), bflo(dd.y), bfhi(dd.y)}; xv[mm][bj][1] = (f32x4){bflo(dd.z), bfhi(dd.z), bflo(dd.w), bfhi(dd.w)}; } }
#pragma unroll
                for (int mm = 0; mm < 2; ++mm) { const int m = 2 * mp + mm, row = row0 + ai * 128 + m * 16; const size_t o = (size_t)row * D + col0; float ss = 0.f;
#pragma unroll
                    for (int bj = 0; bj < 2; ++bj) {
                        const f32x4 y0 = xv[mm][bj][0] + acc[ai][bj][m][0] * 0.5f, y1 = xv[mm][bj][1] + acc[ai][bj][m][1] * 0.5f;
#pragma unroll
                        for (int j = 0; j < 4; ++j) ss += y0[j] * y0[j] + y1[j] * y1[j];
                        *(u32x4*)(x3b + o + bj * 128) = pk8(y0, y1); }
                    ss += __shfl_xor(ss, 16); ss += __shfl_xor(ss, 32);
                    if (fq == 0) rowss[(size_t)row * 16 + u.pn * 4 + wc] = ss; }
            }
    }
};

__device__ __forceinline__ void transpose_item(const float* W, int N, int k0, int n0, const float* kscale, bf16_t* WT, int Kp, int drow0, LAS float* scr, int lane) {
    f32x4 v[8];
#pragma unroll
    for (int j = 0; j < 8; ++j) { const int q = lane + 64 * j, kk = q >> 3, c4 = q & 7; v[j] = *(const f32x4*)(W + (size_t)(k0 + kk) * N + n0 + 4 * c4); }
#pragma unroll
    for (int j = 0; j < 8; ++j) { const int q = lane + 64 * j, kk = q >> 3, c4 = q & 7; const float sc = kscale ? kscale[k0 + kk] : 1.f;
        LAS float* d = scr + kk * 33 + 4 * c4; d[0] = v[j][0] * sc; d[1] = v[j][1] * sc; d[2] = v[j][2] * sc; d[3] = v[j][3] * sc; }
    asm volatile("s_waitcnt lgkmcnt(0)" ::: "memory");
    const int c = lane & 7;
#pragma unroll
    for (int j = 0; j < 4; ++j) { const int n = (lane >> 3) + 8 * j; const LAS float* s = scr + (8 * c) * 33 + n;
        u32x4 o; o.x = cvt_pk_bf16(s[0 * 33], s[1 * 33]); o.y = cvt_pk_bf16(s[2 * 33], s[3 * 33]); o.z = cvt_pk_bf16(s[4 * 33], s[5 * 33]); o.w = cvt_pk_bf16(s[6 * 33], s[7 * 33]);
        *(u32x4*)(WT + (size_t)(drow0 + n) * Kp + k0 + 8 * c) = o; }
    asm volatile("s_waitcnt lgkmcnt(0)" ::: "memory");
}
__device__ __forceinline__ void ffn_weight_item(const float* wg, const float* wu, const float* wd, const float* kscale, bf16_t* WFA, bf16_t* WFD, LAS float* scr, int it, int lane) {
    if (it < 2816) { const int which = it / 1408, r = it % 1408, kb = r / 88, nb = r % 88, n0 = nb * 32;
        transpose_item(which ? wu : wg, FF, kb * 64, n0, kscale, WFA, D, (n0 >> 7) * 256 + (n0 & 127) + which * 128, scr, lane); }
    else { const int r = it - 2816, kb = r / 32, nb = r % 32; transpose_item(wd, D, kb * 64, nb * 32, nullptr, WFD, FF, nb * 32, scr, lane); }
}
constexpr int FFN_W_ITEMS = 3 * 1408;

constexpr int MIX_I_IN = 16 * 129, MIX_I_O = 32 * 32, MIX_W_ITEMS = MIX_I_IN + MIX_I_O;
__device__ __forceinline__ void mix_weight_item(const Params& p, LAS float* scr, int r, int lane) {
    if (r < MIX_I_IN) { const int kb = r / 129, nb = r % 129, n0 = nb * 32; const int drow0 = n0 < 2560 ? n0 : (n0 == 2560 ? 4096 : n0 - 32);
        transpose_item(p.in[7], 4128, kb * 64, n0, p.in[6], (bf16_t*)(p.ws + WS_WIN), D, drow0, scr, lane); return; }
    r -= MIX_I_IN;
    { const int kb = r / 32, nb = r % 32; transpose_item(p.in[17], D, kb * 64, nb * 32, nullptr, (bf16_t*)(p.ws + WS_WOUT), 2048, nb * 32, scr, lane); }
}
__device__ __forceinline__ bool mix_weights_in_p1(int G) { return ((T / 256) * (2 * FF / 256)) % G != 0; }
__device__ __forceinline__ void phase0(const Params& p, LAS unsigned char* lds, int gw, int ngw, int lane, int wave) {
    LAS float* scr = (LAS float*)(lds + wave * 16384);
    const int NIT = FFN_W_ITEMS + (mix_weights_in_p1(gridDim.x) ? 0 : MIX_W_ITEMS);
    for (int it = gw; it < NIT; it += ngw) {
        if (it < FFN_W_ITEMS) { ffn_weight_item(p.in[3], p.in[4], p.in[5], nullptr, (bf16_t*)(p.ws + WS_WFA), (bf16_t*)(p.ws + WS_WFD), scr, it, lane); continue; }
        mix_weight_item(p, scr, it - FFN_W_ITEMS, lane);
    }
    const float* nw = p.in[2]; bf16_t* XN = (bf16_t*)(p.ws + WS_XNB);
    f32x4 wv[4];
#pragma unroll
    for (int j = 0; j < 4; ++j) wv[j] = *(const f32x4*)(nw + 4 * lane + 256 * j);
    for (int m = gw; m < T; m += 2 * ngw) {
        const int m1 = m + ngw; const bool has1 = m1 < T; const int mb = has1 ? m1 : m;
        const float* xr0 = (m < TP ? p.in[0] + (size_t)m * D : p.in[1] + (size_t)(m - TP) * D) + 4 * lane;
        const float* xr1 = (mb < TP ? p.in[0] + (size_t)mb * D : p.in[1] + (size_t)(mb - TP) * D) + 4 * lane;
        f32x4 v0[4], v1[4]; float s0 = 0.f, s1 = 0.f;
#pragma unroll
        for (int j = 0; j < 4; ++j) { v0[j] = __builtin_nontemporal_load((const f32x4*)(xr0 + 256 * j)); v1[j] = __builtin_nontemporal_load((const f32x4*)(xr1 + 256 * j)); }
#pragma unroll
        for (int j = 0; j < 4; ++j) { s0 += (v0[j][0] * v0[j][0] + v0[j][1] * v0[j][1]) + (v0[j][2] * v0[j][2] + v0[j][3] * v0[j][3]); s1 += (v1[j][0] * v1[j][0] + v1[j][1] * v1[j][1]) + (v1[j][2] * v1[j][2] + v1[j][3] * v1[j][3]); }
        const float rs0 = rsqrtf(wave_sum(s0) * (1.f / D) + EPS), rs1 = rsqrtf(wave_sum(s1) * (1.f / D) + EPS);
#pragma unroll
        for (int j = 0; j < 4; ++j) *(u32x2*)(XN + (size_t)m * D + 4 * lane + 256 * j) = pk4(v0[j] * rs0 * wv[j]);
        if (has1) {
#pragma unroll
            for (int j = 0; j < 4; ++j) *(u32x2*)(XN + (size_t)m1 * D + 4 * lane + 256 * j) = pk4(v1[j] * rs1 * wv[j]); }
    }
}

__device__ __forceinline__ void dt_phase(const Params& p, const bf16_t* x1b, int gw, int ngw, int lane) {
    const bf16_t* Wdt = (const bf16_t*)(p.ws + WS_WIN) + (size_t)4096 * D;
    const float* rowss = (const float*)(p.ws + WS_SMALL); float* DT = (float*)(p.ws + WS_DT);
    const int fr = lane & 15, fq = lane >> 4;
    for (int t32 = gw; t32 < T / 32; t32 += ngw) {
        const int row0 = t32 * 32 + fr;
        const bf16_t* ap = x1b + (size_t)row0 * D + 8 * fq; const bf16_t* bp = Wdt + (size_t)fr * D + 8 * fq;
        f32x4 acc[2][2];
#pragma unroll
        for (int a = 0; a < 2; ++a) { acc[a][0] = (f32x4){0.f, 0.f, 0.f, 0.f}; acc[a][1] = acc[a][0]; }
#pragma unroll 8
        for (int ks = 0; ks < 32; ++ks) { const bf16x8 a0 = *(const bf16x8*)(ap + ks * 32), a1 = *(const bf16x8*)(ap + 16 * D + ks * 32), b0 = *(const bf16x8*)(bp + ks * 32), b1 = *(const bf16x8*)(bp + 16 * D + ks * 32);
            acc[0][0] = mfma16(b0, a0, acc[0][0]); acc[0][1] = mfma16(b1, a0, acc[0][1]); acc[1][0] = mfma16(b0, a1, acc[1][0]); acc[1][1] = mfma16(b1, a1, acc[1][1]); }
#pragma unroll
        for (int a = 0; a < 2; ++a) { const int row = row0 + 16 * a; const float rs = row_rs(rowss, row);
#pragma unroll
            for (int nt = 0; nt < 2; ++nt) { const int col = nt * 16 + 4 * fq; const float* bias = (nt ? p.in[11] : p.in[10]) + 4 * fq; f32x4 o;
#pragma unroll
                for (int j = 0; j < 4; ++j) { const float v = acc[a][nt][j] * rs + bias[j]; o[j] = v > 20.f ? v : log1pf(__expf(v)); }
                *(f32x4*)(DT + (size_t)row * 32 + col) = o; } }
    }
}

struct ConvW { f32x4 w[5][2]; f32x4 b[2]; };
__device__ __forceinline__ void load_convw(ConvW& cw, const float* conv_w, const float* conv_b, int c) {
#pragma unroll
    for (int k = 0; k < 5; ++k) { cw.w[k][0] = *(const f32x4*)(conv_w + k * 1536 + c); cw.w[k][1] = *(const f32x4*)(conv_w + k * 1536 + c + 4); }
    cw.b[0] = *(const f32x4*)(conv_b + c); cw.b[1] = *(const f32x4*)(conv_b + c + 4);
}
__device__ __forceinline__ void conv8x2(const bf16_t* xbc, int row, int lo, int hi, int c, const ConvW& cw, f32x4& o0a, f32x4& o0b, f32x4& o1a, f32x4& o1b) {
    f32x4 xa[6], xb[6];
#pragma unroll
    for (int k = 0; k < 6; ++k) { const int r = row + k - 2; const bool ok = (r >= lo) && (r < hi); const int rc = ok ? r : row;
        u32x4 v = *(const u32x4*)(xbc + (size_t)rc * 1536 + c); if (!ok) v = (u32x4){0u, 0u, 0u, 0u};
        xa[k] = (f32x4){bflo(v.x), bfhi(v.x), bflo(v.y), bfhi(v.y)}; xb[k] = (f32x4){bflo(v.z), bfhi(v.z), bflo(v.w), bfhi(v.w)}; }
    o0a = cw.b[0]; o0b = cw.b[1]; o1a = cw.b[0]; o1b = cw.b[1];
#pragma unroll
    for (int k = 0; k < 5; ++k) { o0a += xa[k] * cw.w[k][0]; o0b += xb[k] * cw.w[k][1]; o1a += xa[k + 1] * cw.w[k][0]; o1b += xb[k + 1] * cw.w[k][1]; }
#pragma unroll
    for (int j = 0; j < 4; ++j) { o0a[j] = silu_f(o0a[j]); o0b[j] = silu_f(o0b[j]); o1a[j] = silu_f(o1a[j]); o1b[j] = silu_f(o1b[j]); }
}

#define LBAR() do { asm volatile("s_waitcnt lgkmcnt(0)" ::: "memory"); __builtin_amdgcn_s_barrier(); asm volatile("" ::: "memory"); } while (0)
__device__ __forceinline__ int rho128(int n) { return ((n >> 2) & 7) * 16 + (n >> 5) * 4 + (n & 3); }
__device__ __forceinline__ void ssd_states_item(const Params& p, LAS unsigned char* lds, int cidx, int g, bool fill_wl) {
    int tid = threadIdx.x; asm volatile("" : "+v"(tid));
    const int lane = tid & 63, wave = __builtin_amdgcn_readfirstlane(tid >> 6), fr = lane & 15, fq = lane >> 4;
    LAS float* DTs = (LAS float*)lds;
    LAS float* Ws = DTs + 2048;
    LAS bf16_t* BT = (LAS bf16_t*)(lds + 16384);
    LAS bf16_t* XT0 = BT + 128 * 136;
    LAS bf16_t* WL = XT0 + 4 * 64 * 136;
    const bf16_t* XBC = (const bf16_t*)(p.ws + WS_XBC); const float* DT = (const float*)(p.ws + WS_DT);
    float* CHDEC = (float*)(p.ws + WS_CHDEC); bf16_t* ST = (bf16_t*)p.out;
    const int t0 = cidx * 128, lo = (cidx >> 6) * SEQL, hi = lo + SEQL;
    const int c8 = wave, prow = t0 + 2 * lane;
    u32x4 raw[6]; unsigned keep[8];
    const bf16_t* HALO = (const bf16_t*)(p.ws + WS_HALO); bf16_t* XBCw = (bf16_t*)(p.ws + WS_XBC);
#define A_ISSUE(hh) do { \
        _Pragma("unroll") for (int k = 0; k < 6; ++k) { const int r = prow + k - 2; const bool ok = (r >= lo) && (r < hi); const int colx = g * 512 + (hh) * 64 + c8 * 8; \
            const bf16_t* src = r < t0 ? HALO + ((size_t)(cidx - 1) * 4 + 2 + (r - (t0 - 2))) * 1024 + colx : (r >= t0 + 128 ? HALO + ((size_t)(cidx + 1) * 4 + (r - (t0 + 128))) * 1024 + colx : XBC + (size_t)r * 1536 + colx); \
            raw[k] = *(const u32x4*)(ok ? src : XBC + (size_t)prow * 1536 + colx); if (!ok) raw[k] = (u32x4){0u, 0u, 0u, 0u}; } } while (0)
    __syncthreads();
    A_ISSUE(0);
    for (int i = tid; i < 2048; i += 512) { const int l = i >> 4, j = i & 15; DTs[j * 128 + l] = DT[(size_t)(t0 + l) * 32 + (j >> 3) * 16 + g * 8 + (j & 7)]; }
    if (fill_wl) for (int i = tid; i < 3072; i += 512) { const int k = (i >> 6) % 6, c = (i / 384) * 64 + (i & 63); const float v = k < 5 ? p.in[8][k * 1536 + g * 512 + c] : p.in[9][g * 512 + c];
        WL[i] = (bf16_t)(cvt_pk_bf16(v, 0.f) & 0xffffu); }
    { f32x4 a0, b0, a1, b1, e0, f0, e1, f1; const int cbA = wave, cbB = wave + 8;
        { ConvW cw; load_convw(cw, p.in[8], p.in[9], 1024 + g * 128 + cbA * 8); conv8x2(XBC, t0 + 2 * lane, lo, hi, 1024 + g * 128 + cbA * 8, cw, a0, b0, a1, b1); }
        { ConvW cw; load_convw(cw, p.in[8], p.in[9], 1024 + g * 128 + cbB * 8); conv8x2(XBC, t0 + 2 * lane, lo, hi, 1024 + g * 128 + cbB * 8, cw, e0, f0, e1, f1); }
#pragma unroll
        for (int i = 0; i < 4; ++i) { *(LAS unsigned*)(BT + rho128(cbA * 8 + i) * 136 + 2 * lane) = cvt_pk_bf16(a0[i], a1[i]); *(LAS unsigned*)(BT + rho128(cbA * 8 + 4 + i) * 136 + 2 * lane) = cvt_pk_bf16(b0[i], b1[i]);
            *(LAS unsigned*)(BT + rho128(cbB * 8 + i) * 136 + 2 * lane) = cvt_pk_bf16(e0[i], e1[i]); *(LAS unsigned*)(BT + rho128(cbB * 8 + 4 + i) * 136 + 2 * lane) = cvt_pk_bf16(f0[i], f1[i]); } }
    LBAR();
#pragma unroll
    for (int cc = 0; cc < 2; ++cc) { const int col = 2 * wave + cc, dir = col >> 3, h = col & 7; const float a = -__expf((dir ? p.in[13] : p.in[12])[g * 8 + h]);
        const float d0 = DTs[col * 128 + 2 * lane], d1 = DTs[col * 128 + 2 * lane + 1], v0 = d0 * a, v1 = d1 * a; float x = v0 + v1;
#pragma unroll
        for (int o = 1; o < 64; o <<= 1) { const float t = __shfl_up(x, o); if (lane >= o) x += t; }
        const float tot = __shfl(x, 63);
        const float e0 = dir == 0 ? tot - (x - v1) : x - v0 - v1, e1 = dir == 0 ? tot - x : x - v1;
        Ws[col * 128 + 2 * lane] = d0 * __expf(e0); Ws[col * 128 + 2 * lane + 1] = d1 * __expf(e1);
        if (lane == 0) CHDEC[(cidx * 2 + dir) * 16 + g * 8 + h] = __expf(tot); }
#define A_CONV(hh, XF, XB) do { \
        int tid_h = tid; asm volatile("" : "+v"(tid_h)); \
        const int lane = tid_h & 63, prow = t0 + 2 * lane; \
        f32x4 o0a, o0b, o1a, o1b; f32x4 xa[6], xb[6]; \
        _Pragma("unroll") for (int k = 0; k < 6; ++k) { xa[k] = (f32x4){bflo(raw[k].x), bfhi(raw[k].x), bflo(raw[k].y), bfhi(raw[k].y)}; xb[k] = (f32x4){bflo(raw[k].z), bfhi(raw[k].z), bflo(raw[k].w), bfhi(raw[k].w)}; } \
        { const u32x4 bw = *(const LAS u32x4*)(WL + ((hh) * 6 + 5) * 64 + c8 * 8); o0a = (f32x4){bflo(bw.x), bfhi(bw.x), bflo(bw.y), bfhi(bw.y)}; o0b = (f32x4){bflo(bw.z), bfhi(bw.z), bflo(bw.w), bfhi(bw.w)}; o1a = o0a; o1b = o0b; } \
        _Pragma("unroll") for (int k = 0; k < 5; ++k) { const u32x4 ww = *(const LAS u32x4*)(WL + ((hh) * 6 + k) * 64 + c8 * 8); \
            const f32x4 wa = {bflo(ww.x), bfhi(ww.x), bflo(ww.y), bfhi(ww.y)}, wb = {bflo(ww.z), bfhi(ww.z), bflo(ww.w), bfhi(ww.w)}; \
            o0a += xa[k] * wa; o0b += xb[k] * wb; o1a += xa[k + 1] * wa; o1b += xb[k + 1] * wb; } \
        if ((hh) < 7) A_ISSUE((hh) + 1); \
        const float wf0 = Ws[(hh) * 128 + 2 * lane], wf1 = Ws[(hh) * 128 + 2 * lane + 1], wb0 = Ws[(8 + (hh)) * 128 + 2 * lane], wb1 = Ws[(8 + (hh)) * 128 + 2 * lane + 1]; \
        _Pragma("unroll") for (int i = 0; i < 4; ++i) { const float s0a = silu_f(o0a[i]), s1a = silu_f(o1a[i]), s0b = silu_f(o0b[i]), s1b = silu_f(o1b[i]); \
            keep[i] = cvt_pk_bf16(s0a, s1a); keep[4 + i] = cvt_pk_bf16(s0b, s1b); \
            *(LAS unsigned*)((XF) + (c8 * 8 + i) * 136 + 2 * lane) = cvt_pk_bf16(s0a * wf0, s1a * wf1); *(LAS unsigned*)((XF) + (c8 * 8 + 4 + i) * 136 + 2 * lane) = cvt_pk_bf16(s0b * wf0, s1b * wf1); \
            *(LAS unsigned*)((XB) + (c8 * 8 + i) * 136 + 2 * lane) = cvt_pk_bf16(s0a * wb0, s1a * wb1); *(LAS unsigned*)((XB) + (c8 * 8 + 4 + i) * 136 + 2 * lane) = cvt_pk_bf16(s0b * wb0, s1b * wb1); } } while (0)
#define A_MMA(hh, XF, XB) do { \
        int tid_h = tid; asm volatile("" : "+v"(tid_h)); \
        const int lane = tid_h & 63, fr = lane & 15, fq = lane >> 4; \
        const int dir = wave >> 2, pt = wave & 3; const LAS bf16_t* A = (dir ? (XB) : (XF)) + (pt * 16 + fr) * 136 + 8 * fq; const LAS bf16_t* B = BT + fr * 136 + 8 * fq; \
        f32x4 acc[8]; \
        _Pragma("unroll") for (int nt = 0; nt < 8; ++nt) acc[nt] = (f32x4){0.f, 0.f, 0.f, 0.f}; \
        _Pragma("unroll") for (int ks = 0; ks < 4; ++ks) { const bf16x8 a = *(const LAS bf16x8*)(A + ks * 32); \
            _Pragma("unroll") for (int nt = 0; nt < 8; ++nt) acc[nt] = mfma16(*(const LAS bf16x8*)(B + nt * 16 * 136 + ks * 32), a, acc[nt]); } \
        bf16_t* dst = ST + ((size_t)((cidx * 2 + dir) * 16 + g * 8 + (hh)) * 64 + pt * 16 + fr) * 128 + 32 * fq; \
        _Pragma("unroll") for (int nt = 0; nt < 8; nt += 2) *(u32x4*)(dst + nt * 4) = pk8(acc[nt], acc[nt + 1]); } while (0)
#define A_WRITEBACK(hh) do { \
        int tid_w = tid; asm volatile("" : "+v"(tid_w)); const int lw = tid_w & 63; \
        _Pragma("unroll") for (int i = 0; i < 8; ++i) *(unsigned*)(XBCw + (size_t)(t0 + 2 * (c8 * 8 + i) + (lw >> 5)) * 1536 + g * 512 + (hh) * 64 + ((2 * lw) & 63)) = keep[i]; } while (0)
    LBAR();
    A_CONV(0, XT0, XT0 + 64 * 136);
    LBAR();
#pragma unroll 1
    for (int h = 0; h < 8; ++h) {
        LAS bf16_t* cur = XT0 + (h & 1) * (2 * 64 * 136); LAS bf16_t* nxt = XT0 + ((h + 1) & 1) * (2 * 64 * 136);
        A_WRITEBACK(h);
#pragma unroll 1
        for (int st = 0; st < 2; ++st) {
            if ((st == 0) == (wave < 4)) { if (h < 7) A_CONV(h + 1, nxt, nxt + 64 * 136); }
            else A_MMA(h, cur, cur + 64 * 136); }
        LBAR();
    }
#undef A_CONV
#undef A_MMA
#undef A_WRITEBACK
#undef A_ISSUE
}

__device__ __forceinline__ void ssd_scan_phase(const Params& p) {
    bf16_t* ST = (bf16_t*)p.out; const float* CHDEC = (const float*)(p.ws + WS_CHDEC);
    for (int it = blockIdx.x * 512 + threadIdx.x; it < 6 * 2 * 16 * 1024; it += gridDim.x * 512) {
        const int e8 = it & 1023, head = (it >> 10) & 15, dir = (it >> 14) & 1, seq = it >> 15;
        f32x4 c0 = {0.f, 0.f, 0.f, 0.f}, c1 = c0;
#pragma unroll 1
        for (int sb = 0; sb < 8; ++sb) {
            u32x4 v[8]; float dec[8];
#pragma unroll
            for (int k = 0; k < 8; ++k) { const int step = sb * 8 + k, cidx = seq * 64 + (dir ? 63 - step : step);
                v[k] = __builtin_nontemporal_load((const u32x4*)(ST + ((size_t)((cidx * 2 + dir) * 16 + head) * 8192) + e8 * 8)); dec[k] = CHDEC[(cidx * 2 + dir) * 16 + head]; }
#pragma unroll
            for (int k = 0; k < 8; ++k) { const int step = sb * 8 + k, cidx = seq * 64 + (dir ? 63 - step : step);
                *(u32x4*)(ST + ((size_t)((cidx * 2 + dir) * 16 + head) * 8192) + e8 * 8) = pk8(c0, c1);
                c0 = c0 * dec[k] + (f32x4){bflo(v[k].x), bfhi(v[k].x), bflo(v[k].y), bfhi(v[k].y)}; c1 = c1 * dec[k] + (f32x4){bflo(v[k].z), bfhi(v[k].z), bflo(v[k].w), bfhi(v[k].w)}; }
        }
    }
}

__device__ __forceinline__ int rho64(int pcol) { return ((pcol >> 2) & 3) * 16 + (pcol >> 4) * 4 + (pcol & 3); }
__device__ __forceinline__ void ssd_out_item(const Params& p, LAS unsigned char* lds, int cidx, int g) {
    int tid = threadIdx.x; asm volatile("" : "+v"(tid));
    const int lane = tid & 63, wave = __builtin_amdgcn_readfirstlane(tid >> 6), fr = lane & 15, fq = lane >> 4;
    LAS float* DTF = (LAS float*)lds; LAS float* DTB = DTF + 1024; LAS float* CSF = DTB + 1024; LAS float* SFB = CSF + 1024;
    LAS bf16_t* Cm = (LAS bf16_t*)(lds + 16384);
    LAS bf16_t* Bm = Cm + 128 * 136;
    LAS bf16_t* XT = Bm + 128 * 136;
    LAS bf16_t* PF = XT + 64 * 136; LAS bf16_t* PB = PF + 64 * 136;
    LAS bf16_t* WL = PB + 64 * 136;
    const bf16_t* XBC = (const bf16_t*)(p.ws + WS_XBC); const float* DT = (const float*)(p.ws + WS_DT);
    const bf16_t* ST = (const bf16_t*)p.out; bf16_t* ZQ = (bf16_t*)(p.ws + WS_ZQ);
    const int t0 = cidx * 128, lo = (cidx >> 6) * SEQL, hi = lo + SEQL;
    __syncthreads();
    const bool first_item = (cidx == 0 && g == 0); ISTAMP(first_item, 24);
    for (int i = tid; i < 2048; i += 512) { const int l = i >> 4, j = i & 15; DTF[j * 128 + l] = DT[(size_t)(t0 + l) * 32 + (j >> 3) * 16 + g * 8 + (j & 7)]; }
#pragma unroll 1
    for (int rep = 0; rep < 2; ++rep) { const int c8 = wave + 8 * rep, colB = 1024 + g * 128 + c8 * 8, colC = colB + 256;
        f32x4 a0, b0, a1, b1, e0, f0, e1, f1;
        { ConvW cw; load_convw(cw, p.in[8], p.in[9], colB); conv8x2(XBC, t0 + 2 * lane, lo, hi, colB, cw, a0, b0, a1, b1); }
        { ConvW cw; load_convw(cw, p.in[8], p.in[9], colC); conv8x2(XBC, t0 + 2 * lane, lo, hi, colC, cw, e0, f0, e1, f1); }
        LAS bf16_t* dB = Bm + (2 * lane) * 136 + c8 * 8; LAS bf16_t* dC = Cm + (2 * lane) * 136 + c8 * 8;
        *(LAS u32x4*)dB = pk8(a0, b0); *(LAS u32x4*)(dB + 136) = pk8(a1, b1); *(LAS u32x4*)dC = pk8(e0, f0); *(LAS u32x4*)(dC + 136) = pk8(e1, f1); }
    __syncthreads();
#pragma unroll
    for (int cc = 0; cc < 2; ++cc) { const int col = 2 * wave + cc, dir = col >> 3, h = col & 7; const float a = -__expf((dir ? p.in[13] : p.in[12])[g * 8 + h]);
        const float v0 = DTF[col * 128 + 2 * lane] * a, v1 = DTF[col * 128 + 2 * lane + 1] * a; float x = v0 + v1;
#pragma unroll
        for (int o = 1; o < 64; o <<= 1) { const float t = __shfl_up(x, o); if (lane >= o) x += t; }
        const float tot = __shfl(x, 63);
        if (dir == 0) { CSF[h * 128 + 2 * lane] = x - v1; CSF[h * 128 + 2 * lane + 1] = x; }
        else { SFB[h * 128 + 2 * lane] = tot - x + v0 + v1; SFB[h * 128 + 2 * lane + 1] = tot - x + v1; } }
    f32x4 cb[8];
    { const LAS bf16_t* A = Cm + (wave * 16 + fr) * 136 + 8 * fq; const LAS bf16_t* B = Bm + fr * 136 + 8 * fq;
#pragma unroll
      for (int nt = 0; nt < 8; ++nt) cb[nt] = (f32x4){0.f, 0.f, 0.f, 0.f};
#pragma unroll
      for (int ks = 0; ks < 4; ++ks) { const bf16x8 a = *(const LAS bf16x8*)(A + ks * 32);
#pragma unroll
          for (int nt = 0; nt < 8; ++nt) cb[nt] = mfma16(*(const LAS bf16x8*)(B + nt * 16 * 136 + ks * 32), a, cb[nt]); } }
    const int l = wave * 16 + fr; const size_t zrow = (size_t)(t0 + l) * 2048 + g * 512;
    float ss = 0.f;
    const int c8 = wave; const int prow = t0 + 2 * lane;
    u32x4 raw[2], prv[4];
#define C_ISSUE(hh) do { \
        _Pragma("unroll") for (int k = 0; k < 2; ++k) { const int q = tid + 512 * k, pp = q >> 4, l0 = (q & 15) * 8; raw[k] = *(const u32x4*)(XBC + (size_t)(t0 + 2 * pp + (l0 >> 6)) * 1536 + g * 512 + (hh) * 64 + (l0 & 63)); } \
        _Pragma("unroll") for (int k = 0; k < 4; ++k) { const int i = tid + 512 * k, which = i >> 10, r = (i >> 4) & 63, c = i & 15; prv[k] = *(const u32x4*)(ST + ((size_t)((cidx * 2 + which) * 16 + g * 8 + (hh)) * 64 + r) * 128 + c * 8); } \
        } while (0)
    C_ISSUE(0);
    ISTAMP(first_item, 25);
#pragma unroll 1
    for (int h = 0; h < 8; ++h) {
        LBAR();
        int tid_h = tid; asm volatile("" : "+v"(tid_h));
        const int tid = tid_h, lane = tid & 63, fr = lane & 15, fq = lane >> 4, l = wave * 16 + fr, prow = t0 + 2 * lane; const size_t zrow = (size_t)(t0 + l) * 2048 + g * 512;
#pragma unroll
        for (int k = 0; k < 2; ++k) { const int q = tid + 512 * k, pp = q >> 4, l0 = (q & 15) * 8; *(LAS u32x4*)(XT + rho64(pp) * 136 + l0) = raw[k]; }
#pragma unroll
        for (int k = 0; k < 4; ++k) { const int i = tid + 512 * k, which = i >> 10, r = (i >> 4) & 63, c = i & 15; *(LAS u32x4*)((which ? PB : PF) + rho64(r) * 136 + c * 8) = prv[k]; }
        if (h < 7) C_ISSUE(h + 1);
        const float csl = CSF[h * 128 + l], sbl = SFB[h * 128 + l], dtl = DTF[h * 128 + l] + DTB[h * 128 + l], dsk = p.in[14][g * 8 + h];
#pragma unroll
        for (int nt = 0; nt < 8; ++nt) { const int s0 = nt * 16 + 4 * fq; f32x4 gv;
            if (nt < wave) { const f32x4 cs4 = *(const LAS f32x4*)(CSF + h * 128 + s0), df4 = *(const LAS f32x4*)(DTF + h * 128 + s0);
#pragma unroll
                for (int r = 0; r < 4; ++r) gv[r] = cb[nt][r] * (__expf(csl - cs4[r]) * df4[r]); }
            else if (nt > wave) { const f32x4 sb4 = *(const LAS f32x4*)(SFB + h * 128 + s0), db4 = *(const LAS f32x4*)(DTB + h * 128 + s0);
#pragma unroll
                for (int r = 0; r < 4; ++r) gv[r] = cb[nt][r] * (__expf(sbl - sb4[r]) * db4[r]); }
            else { const f32x4 cs4 = *(const LAS f32x4*)(CSF + h * 128 + s0), df4 = *(const LAS f32x4*)(DTF + h * 128 + s0), sb4 = *(const LAS f32x4*)(SFB + h * 128 + s0), db4 = *(const LAS f32x4*)(DTB + h * 128 + s0);
#pragma unroll
                for (int r = 0; r < 4; ++r) { const int s = s0 + r; const float e = __expf(s < l ? csl - cs4[r] : sbl - sb4[r]) * (s < l ? df4[r] : db4[r]); gv[r] = cb[nt][r] * (s == l ? dtl : e) + (s == l ? dsk : 0.f); } }
            *(LAS u32x2*)(Bm + l * 136 + s0) = pk4(gv); }
        LBAR();
        const u32x4 z0 = *(const u32x4*)(ZQ + zrow + h * 64 + 16 * fq), z1 = *(const u32x4*)(ZQ + zrow + h * 64 + 16 * fq + 8);
        f32x4 aY[4], aF[4], aB[4];
#pragma unroll
        for (int d = 0; d < 4; ++d) { aY[d] = (f32x4){0.f, 0.f, 0.f, 0.f}; aF[d] = aY[d]; aB[d] = aY[d]; }
#pragma unroll
        for (int ks = 0; ks < 4; ++ks) { const bf16x8 ag = *(const LAS bf16x8*)(Bm + l * 136 + ks * 32 + 8 * fq), ac = *(const LAS bf16x8*)(Cm + l * 136 + ks * 32 + 8 * fq);
#pragma unroll
            for (int d = 0; d < 4; ++d) { const int bo = (d * 16 + fr) * 136 + ks * 32 + 8 * fq;
                aY[d] = mfma16(*(const LAS bf16x8*)(XT + bo), ag, aY[d]); aF[d] = mfma16(*(const LAS bf16x8*)(PF + bo), ac, aF[d]); aB[d] = mfma16(*(const LAS bf16x8*)(PB + bo), ac, aB[d]);
                if (d & 1) asm volatile("" ::: "memory"); } }
        const float ef = __expf(csl), eb = __expf(sbl);
        f32x4 y[4];
        { const unsigned zz[8] = {z0.x, z0.y, z0.z, z0.w, z1.x, z1.y, z1.z, z1.w};
#pragma unroll
          for (int d = 0; d < 4; ++d) { y[d] = aY[d] + aF[d] * ef + aB[d] * eb;
              const f32x4 z4 = {bflo(zz[2 * d]), bfhi(zz[2 * d]), bflo(zz[2 * d + 1]), bfhi(zz[2 * d + 1])};
#pragma unroll
              for (int j = 0; j < 4; ++j) { y[d][j] *= silu_f(z4[j]); ss += y[d][j] * y[d][j]; } } }
        *(u32x4*)(ZQ + zrow + h * 64 + 16 * fq) = pk8(y[0], y[1]); *(u32x4*)(ZQ + zrow + h * 64 + 16 * fq + 8) = pk8(y[2], y[3]);
    }
#undef C_ISSUE
    ISTAMP(first_item, 26);
    ss += __shfl_xor(ss, 16); ss += __shfl_xor(ss, 32);
    const float rstd = rsqrtf(ss * (1.f / 512.f) + EPS); const float* nw = p.in[15] + g * 512;
    u32x4 yv[16];
#pragma unroll
    for (int i = 0; i < 16; ++i) yv[i] = *(const u32x4*)(ZQ + zrow + (i >> 1) * 64 + 16 * fq + (i & 1) * 8);
#pragma unroll
    for (int i = 0; i < 16; ++i) { const int pc = (i >> 1) * 64 + 16 * fq + (i & 1) * 8; const f32x4 w0 = *(const f32x4*)(nw + pc), w1 = *(const f32x4*)(nw + pc + 4);
        const f32x4 ya = {bflo(yv[i].x) * rstd * w0[0], bfhi(yv[i].x) * rstd * w0[1], bflo(yv[i].y) * rstd * w0[2], bfhi(yv[i].y) * rstd * w0[3]};
        const f32x4 yb = {bflo(yv[i].z) * rstd * w1[0], bfhi(yv[i].z) * rstd * w1[1], bflo(yv[i].w) * rstd * w1[2], bfhi(yv[i].w) * rstd * w1[3]};
        *(u32x4*)(ZQ + zrow + pc) = pk8(ya, yb); }
    ISTAMP(first_item, 27);
}

struct AttnPre { u32x4 k[6], v0[3], v1[3]; };
__device__ __forceinline__ void attn_issue(const Params& p, AttnPre& pre, int tid, int lane, int wave, int seq, int qb, int kvh) {
    const bf16_t* KV = (const bf16_t*)(p.ws + WS_KV); const int qs = qb * 128, rowbase = seq * SEQL;
#pragma unroll
    for (int it = 0; it < 6; ++it) { const int idx = tid + 512 * it, j = idx >> 3, c = idx & 7, sp = qs - 128 + j; const bool ok = sp >= 0 && sp < SEQL;
        pre.k[it] = *(const u32x4*)(KV + (size_t)(rowbase + (ok ? sp : qs)) * 512 + kvh * 64 + c * 8); if (!ok) pre.k[it] = (u32x4){0u, 0u, 0u, 0u}; }
#pragma unroll
    for (int it = 0; it < 3; ++it) { const int j0 = 2 * (lane + 64 * it), sp = qs - 128 + j0; const bool ok = sp >= 0 && sp < SEQL;
        const bf16_t* src = KV + (size_t)(rowbase + (ok ? sp : qs)) * 512 + 256 + kvh * 64 + wave * 8;
        pre.v0[it] = *(const u32x4*)src; pre.v1[it] = *(const u32x4*)(src + 512); if (!ok) { pre.v0[it] = (u32x4){0u, 0u, 0u, 0u}; pre.v1[it] = pre.v0[it]; } }
}
template <int NT0, int NT1>
__device__ __forceinline__ void attn_block(const LAS bf16_t* Ks, const LAS bf16_t* VT, int kb, int c0, int fr, int fq, float basef, float slope2, float sc2,
                                           const bf16x8 q0, const bf16x8 q1, f32x4 (&O)[4], float& mrun, float& lrun) {
    f32x4 s[8];
#pragma unroll
    for (int nt = NT0; nt < NT1; ++nt) { s[nt] = (f32x4){0.f, 0.f, 0.f, 0.f};
        s[nt] = mfma16(*(const LAS bf16x8*)(Ks + (kb * 128 + nt * 16 + fr) * 72 + 8 * fq), q0, s[nt]);
        s[nt] = mfma16(*(const LAS bf16x8*)(Ks + (kb * 128 + nt * 16 + fr) * 72 + 32 + 8 * fq), q1, s[nt]); }
    float tmax = -INFINITY;
#pragma unroll
    for (int nt = NT0; nt < NT1; ++nt) { const int c = c0 - 16 * nt; const float scf = ((float)c + basef) * slope2;
        const float thr = (c > 128 || c < -128) ? -1.f : ((c == 128 || c == -128) ? 128.5f * slope2 : INFINITY);
#pragma unroll
        for (int r = 0; r < 4; ++r) { const float at = fabsf(scf - slope2 * (float)r); const float v = at > thr ? -INFINITY : fmaf(s[nt][r], sc2, -at); s[nt][r] = v; tmax = fmaxf(tmax, v); } }
    tmax = fmaxf(tmax, __shfl_xor(tmax, 16)); tmax = fmaxf(tmax, __shfl_xor(tmax, 32));
    const float mnew = fmaxf(mrun, tmax), alpha = __builtin_amdgcn_exp2f(mrun - mnew); float rsum = 0.f;
#pragma unroll
    for (int nt = NT0; nt < NT1; ++nt)
#pragma unroll
        for (int r = 0; r < 4; ++r) { const float pv = __builtin_amdgcn_exp2f(s[nt][r] - mnew); s[nt][r] = pv; rsum += pv; }
    rsum += __shfl_xor(rsum, 16); rsum += __shfl_xor(rsum, 32);
    lrun = lrun * alpha + rsum; mrun = mnew;
#pragma unroll
    for (int d = 0; d < 4; ++d) O[d] *= alpha;
#pragma unroll
    for (int k = NT0 / 2; k < NT1 / 2; ++k) {
        const u32x2 pa = pk4(s[2 * k]), pb = pk4(s[2 * k + 1]); const u32x4 pw = {pa.x, pa.y, pb.x, pb.y}; const bf16x8 pf = __builtin_bit_cast(bf16x8, pw);
#pragma unroll
        for (int d = 0; d < 4; ++d) { const LAS bf16_t* vp = VT + (d * 16 + fr) * 392 + kb * 128 + k * 32 + 4 * fq;
            const u32x2 va = *(const LAS u32x2*)vp, vb = *(const LAS u32x2*)(vp + 16); const u32x4 vw = {va.x, va.y, vb.x, vb.y};
            O[d] = mfma16(__builtin_bit_cast(bf16x8, vw), pf, O[d]); } }
}
__device__ __forceinline__ void attn_item(const Params& p, LAS unsigned char* lds, AttnPre& pre, int seq, int qb, int kvh, int nseq, int nqb, int nkvh) {
    int tid = threadIdx.x; asm volatile("" : "+v"(tid));
    const int lane = tid & 63, wave = __builtin_amdgcn_readfirstlane(tid >> 6), fr = lane & 15, fq = lane >> 4;
    LAS bf16_t* Ks = (LAS bf16_t*)lds;
    LAS bf16_t* VT = Ks + 384 * 72;
    LAS bf16_t* Pw = VT + 64 * 392 + wave * (16 * 136);
    bf16_t* ZQ = (bf16_t*)(p.ws + WS_ZQ);
    const int qs = qb * 128, rowbase = seq * SEQL;
    LBAR();
#pragma unroll
    for (int it = 0; it < 6; ++it) { const int idx = tid + 512 * it, j = idx >> 3, c = idx & 7; *(LAS u32x4*)(Ks + j * 72 + c * 8) = pre.k[it]; }
#pragma unroll
    for (int it = 0; it < 3; ++it) { const int j0 = 2 * (lane + 64 * it); const u32x4 v0 = pre.v0[it], v1 = pre.v1[it];
        LAS bf16_t* dst = VT + (wave * 8) * 392 + j0;
        *(LAS unsigned*)(dst + 0 * 392) = (v0.x & 0xffffu) | (v1.x << 16); *(LAS unsigned*)(dst + 1 * 392) = (v0.x >> 16) | (v1.x & 0xffff0000u);
        *(LAS unsigned*)(dst + 2 * 392) = (v0.y & 0xffffu) | (v1.y << 16); *(LAS unsigned*)(dst + 3 * 392) = (v0.y >> 16) | (v1.y & 0xffff0000u);
        *(LAS unsigned*)(dst + 4 * 392) = (v0.z & 0xffffu) | (v1.z << 16); *(LAS unsigned*)(dst + 5 * 392) = (v0.z >> 16) | (v1.z & 0xffff0000u);
        *(LAS unsigned*)(dst + 6 * 392) = (v0.w & 0xffffu) | (v1.w << 16); *(LAS unsigned*)(dst + 7 * 392) = (v0.w >> 16) | (v1.w & 0xffff0000u); }
    const int hq = kvh * 4 + (wave >> 1), r0 = qs + 64 * (wave & 1);
    bf16_t* qbase = ZQ + (size_t)(rowbase + r0 + fr) * 2048 + 1024 + hq * 64;
    bf16x8 qf[4][2];
#pragma unroll
    for (int mt = 0; mt < 4; ++mt)
#pragma unroll
        for (int k = 0; k < 2; ++k) qf[mt][k] = *(const bf16x8*)(qbase + (size_t)mt * 16 * 2048 + k * 32 + 8 * fq);
    if (nseq >= 0) attn_issue(p, pre, tid, lane, wave, nseq, nqb, nkvh);
    LBAR();
    const float slope2 = __builtin_amdgcn_exp2f(-0.5f * (float)(hq + 1)) * LOG2E, sink2 = p.in[16][hq] * LOG2E, sc2 = 0.125f * LOG2E;
    const float basef = (float)(fr - 4 * fq); const int half = wave & 1;
#pragma unroll 1
    for (int mt = 0; mt < 4; ++mt) {
        const bf16x8 q0 = mt == 0 ? qf[0][0] : (mt == 1 ? qf[1][0] : (mt == 2 ? qf[2][0] : qf[3][0]));
        const bf16x8 q1 = mt == 0 ? qf[0][1] : (mt == 1 ? qf[1][1] : (mt == 2 ? qf[2][1] : qf[3][1]));
        f32x4 O[4]; float mrun = sink2, lrun = 1.f;
#pragma unroll
        for (int d = 0; d < 4; ++d) O[d] = (f32x4){0.f, 0.f, 0.f, 0.f};
#pragma unroll 1
        for (int kb = 0; kb < 3; ++kb) {
            if ((kb == 0 && qb == 0) || (kb == 2 && qb == 63)) continue;
            const int c0 = 64 * half + 16 * mt + 128 - 128 * kb;
            if (c0 - 112 > 128 || c0 < -128) continue;
            if (c0 - 48 > 128) attn_block<4, 8>(Ks, VT, kb, c0, fr, fq, basef, slope2, sc2, q0, q1, O, mrun, lrun);
            else if (c0 - 64 < -128) attn_block<0, 4>(Ks, VT, kb, c0, fr, fq, basef, slope2, sc2, q0, q1, O, mrun, lrun);
            else attn_block<0, 8>(Ks, VT, kb, c0, fr, fq, basef, slope2, sc2, q0, q1, O, mrun, lrun);
        }
        const float inv = 1.f / lrun;
#pragma unroll
        for (int d = 0; d < 4; ++d) *(u32x2*)(qbase + (size_t)mt * 16 * 2048 + d * 16 + 4 * fq) = pk4(O[d] * inv);
    }
}

__device__ __forceinline__ void final_norm_phase(const Params& p, int gw, int ngw, int lane) {
    const float* rowss = (const float*)(p.ws + WS_SMALL) + (size_t)2 * T * 16; const float* nw = p.in[22]; const bf16_t* x3b = (const bf16_t*)(p.ws + WS_XNB);
    f32x4 w0 = *(const f32x4*)(nw + 8 * lane), w1 = *(const f32x4*)(nw + 8 * lane + 4), w2 = *(const f32x4*)(nw + 512 + 8 * lane), w3 = *(const f32x4*)(nw + 512 + 8 * lane + 4);
    for (int m = gw; m < T; m += 2 * ngw) {
        const int m1 = m + ngw; const bool has1 = m1 < T; const int mb = has1 ? m1 : m;
        const u32x4 a0 = *(const u32x4*)(x3b + (size_t)m * D + 8 * lane), b0 = *(const u32x4*)(x3b + (size_t)m * D + 512 + 8 * lane);
        const u32x4 a1 = *(const u32x4*)(x3b + (size_t)mb * D + 8 * lane), b1 = *(const u32x4*)(x3b + (size_t)mb * D + 512 + 8 * lane);
        const float rs0 = row_rs(rowss, m), rs1 = row_rs(rowss, mb);
        { float* xr = p.out + (size_t)m * D + 8 * lane;
          *(f32x4*)(xr) = (f32x4){bflo(a0.x), bfhi(a0.x), bflo(a0.y), bfhi(a0.y)} * rs0 * w0; *(f32x4*)(xr + 4) = (f32x4){bflo(a0.z), bfhi(a0.z), bflo(a0.w), bfhi(a0.w)} * rs0 * w1;
          *(f32x4*)(xr + 512) = (f32x4){bflo(b0.x), bfhi(b0.x), bflo(b0.y), bfhi(b0.y)} * rs0 * w2; *(f32x4*)(xr + 516) = (f32x4){bflo(b0.z), bfhi(b0.z), bflo(b0.w), bfhi(b0.w)} * rs0 * w3; }
        if (has1) { float* xr = p.out + (size_t)m1 * D + 8 * lane;
          *(f32x4*)(xr) = (f32x4){bflo(a1.x), bfhi(a1.x), bflo(a1.y), bfhi(a1.y)} * rs1 * w0; *(f32x4*)(xr + 4) = (f32x4){bflo(a1.z), bfhi(a1.z), bflo(a1.w), bfhi(a1.w)} * rs1 * w1;
          *(f32x4*)(xr + 512) = (f32x4){bflo(b1.x), bfhi(b1.x), bflo(b1.y), bfhi(b1.y)} * rs1 * w2; *(f32x4*)(xr + 516) = (f32x4){bflo(b1.z), bfhi(b1.z), bflo(b1.w), bfhi(b1.w)} * rs1 * w3; }
    }
}

__device__ __forceinline__ RsTab rs_table_build(LAS unsigned char* lds, const pg8::StaticOrder& S, const float* part) {
    RsTab t; t.tab = (const LAS float*)(lds + 131072); t.g0 = 0; t.ok = 0;
    pg8::Unit u; if (!S.next(0, u)) return t;
    const int k = u.pm & 7; int gmin = u.pm >> 3, gmax = gmin, good = 1;
    for (int i = 1; S.next(i, u); ++i) { const int gq = u.pm >> 3; gmin = gq < gmin ? gq : gmin; gmax = gq > gmax ? gq : gmax; good &= ((u.pm & 7) == k); }
    if (!good || gmax - gmin >= 8) return t;
    LAS float* w = (LAS float*)(lds + 131072);
    for (int i = threadIdx.x; i < (gmax - gmin + 1) * 256; i += 512) { const int row = (((gmin + (i >> 8)) << 3) + k) * 256 + (i & 255); w[i] = row_rs(part, row); }
    __syncthreads();
    t.g0 = gmin; t.ok = 1; return t;
}
constexpr int NPHASE = 10;
__global__ void __launch_bounds__(512, 2) hymba_fwd(Params p, int ph_lo, int ph_hi) {
    extern __shared__ __attribute__((aligned(16))) unsigned char lds_raw[];
    LAS unsigned char* lds = (LAS unsigned char*)lds_raw;
    const int tid = threadIdx.x, lane = tid & 63, wave = __builtin_amdgcn_readfirstlane(tid >> 6);
    const int G = gridDim.x, bx = blockIdx.x, gw = bx * 8 + wave, ngw = G * 8;
    unsigned char* ws = p.ws;
    float* rowss = (float*)(ws + WS_SMALL);
    bf16_t* XNB = (bf16_t*)(ws + WS_XNB); bf16_t* Hb = (bf16_t*)(ws + WS_H); bf16_t* X1B = (bf16_t*)p.out;
#if MK_LAUNCH_PER_PHASE
#define SEAM(k) do { } while (0)
#else
    cg::grid_group grid = cg::this_grid();
    if (tid < 8) ((LAS unsigned*)(lds + LDS_BYTES - 64))[tid] = 0u;
    __syncthreads();
    const XcdBarrier xbar = xcd_barrier_post((unsigned*)(ws + WS_BAR), (volatile LAS unsigned*)(lds + LDS_BYTES - 64));
    if (ph_lo < 0) grid.sync();
#define SEAM(k) do { if (ph_lo <= (k) && (k) + 1 < ph_hi) xcd_barrier(xbar); } while (0)
#endif
#ifdef ONLY
#define IN(k) ((k) == ONLY && ph_lo <= (k) && (k) < ph_hi)
#else
#define IN(k) (ph_lo <= (k) && (k) < ph_hi)
#endif
#ifdef TSA
    unsigned long long* TS = (unsigned long long*)(ws + WS_CHDEC + 65536);
#define STAMP(k) do { if (bx == 0 && tid == 0) TS[k] = __builtin_amdgcn_s_memrealtime(); } while (0)
#else
#define STAMP(k) do { } while (0)
#endif
    STAMP(0);
    if (IN(0)) { phase0(p, lds, gw, ngw, lane, wave); }
#if defined(DUP) && DUP == 0
    __syncthreads(); phase0(p, lds, gw, ngw, lane, wave);
#endif
    SEAM(0); STAMP(1);
    if (IN(1)) { pg8::Gemm g{XNB, (const bf16_t*)(ws + WS_WFA), T, 2 * FF, D}; pg8::StaticOrder S; S.init(T, 2 * FF, G, bx); EpiGateUp<false> E{Hb, nullptr, RsTab{nullptr, 0, 0}};
        pg8::gemm_phase<EpiGateUp<false>, pg8::StaticOrder, true, true>(lds, g, S, E);
        if (mix_weights_in_p1(G)) { const int heavy = ((T / 256) * (2 * FF / 256)) % G;
            if (bx >= heavy) { LAS float* scr = (LAS float*)(lds + wave * 16384);
                for (int it = (bx - heavy) * 8 + wave; it < MIX_W_ITEMS + 2816; it += (G - heavy) * 8) {
                    if (it < MIX_W_ITEMS) mix_weight_item(p, scr, it, lane);
                    else ffn_weight_item(p.in[19], p.in[20], p.in[21], p.in[18], (bf16_t*)(ws + WS_W2A), (bf16_t*)(ws + WS_W2D), scr, it - MIX_W_ITEMS, lane); } } }
#if defined(DUP) && DUP == 1
        pg8::gemm_phase<EpiGateUp<false>, pg8::StaticOrder, true, true>(lds, g, S, E);
#endif
    }
    SEAM(1); STAMP(2);
    if (IN(2)) { pg8::Gemm g{Hb, (const bf16_t*)(ws + WS_WFD), T, D, FF}; pg8::StaticOrder S; S.init(T, D, G, bx); EpiDown1 E{p.in[0], p.in[1], XNB, rowss};
        pg8::gemm_phase<EpiDown1, pg8::StaticOrder, true, true>(lds, g, S, E); }
    SEAM(2); STAMP(3);
    if (IN(3)) { pg8::Gemm g{XNB, (const bf16_t*)(ws + WS_WIN), T, 4096, D}; pg8::StaticOrder S; S.init(T, 4096, G, bx);
        EpiInProj E{(bf16_t*)(ws + WS_ZQ), (bf16_t*)(ws + WS_XBC), (bf16_t*)(ws + WS_KV), rowss, rs_table_build(lds, S, rowss), (bf16_t*)(ws + WS_HALO)};
        pg8::gemm_phase<EpiInProj, pg8::StaticOrder, true, true>(lds, g, S, E);
        dt_phase(p, XNB, gw, ngw, lane); }
    SEAM(3); STAMP(4);
    if (IN(4)) {
        int it = bx;
        for (; it < 768; it += G) ssd_states_item(p, lds, it >> 1, it & 1, (G & 1) || it == bx);
        STAMP(12);
        __syncthreads();
        if (it < 768 + 1536) {
            AttnPre pre; { const int a = it - 768; attn_issue(p, pre, tid, lane, wave, a / 256, (a >> 2) & 63, a & 3); }
            for (; it < 768 + 1536; it += G) { const int a = it - 768, an = a + G; const bool more = it + G < 768 + 1536;
                attn_item(p, lds, pre, a / 256, (a >> 2) & 63, a & 3, more ? an / 256 : -1, (an >> 2) & 63, an & 3); }
        }
    }
#if defined(DUP) && DUP == 4
    for (int it = bx; it < 768; it += G) ssd_states_item(p, lds, it >> 1, it & 1, true);
#endif
    STAMP(20);
    SEAM(4); STAMP(5);
    if (IN(5)) { ssd_scan_phase(p); }
    SEAM(5); STAMP(6);
    if (IN(6)) { for (int it = bx; it < 768; it += G) ssd_out_item(p, lds, it >> 1, it & 1); }
    SEAM(6); STAMP(7);
    if (IN(7)) {
        __syncthreads();
        if (!mix_weights_in_p1(G)) { LAS float* scr = (LAS float*)(lds + wave * 16384); for (int it = gw; it < FFN_W_ITEMS; it += ngw) ffn_weight_item(p.in[19], p.in[20], p.in[21], p.in[18], (bf16_t*)(ws + WS_W2A), (bf16_t*)(ws + WS_W2D), scr, it, lane); }
        __syncthreads();
        pg8::Gemm g{(const bf16_t*)(ws + WS_ZQ), (const bf16_t*)(ws + WS_WOUT), T, D, 2048}; pg8::StaticOrder S; S.init(T, D, G, bx); EpiOutProj E{XNB, rowss + (size_t)T * 16};
        pg8::gemm_phase<EpiOutProj, pg8::StaticOrder, true, true>(lds, g, S, E); }
    SEAM(7); STAMP(8);
    if (IN(8)) { pg8::Gemm g{XNB, (const bf16_t*)(ws + WS_W2A), T, 2 * FF, D}; pg8::StaticOrder S; S.init(T, 2 * FF, G, bx); EpiGateUp<true> E{Hb, rowss + (size_t)T * 16, rs_table_build(lds, S, rowss + (size_t)T * 16)};
        pg8::gemm_phase<EpiGateUp<true>, pg8::StaticOrder, true, true>(lds, g, S, E);
        if (mix_weights_in_p1(G)) { const int heavy = ((T / 256) * (2 * FF / 256)) % G;
            if (bx >= heavy) { LAS float* scr = (LAS float*)(lds + wave * 16384);
                for (int it = 2816 + (bx - heavy) * 8 + wave; it < FFN_W_ITEMS; it += (G - heavy) * 8)
                    ffn_weight_item(p.in[19], p.in[20], p.in[21], p.in[18], (bf16_t*)(ws + WS_W2A), (bf16_t*)(ws + WS_W2D), scr, it, lane); } } }
    SEAM(8); STAMP(9);
    if (IN(9)) { pg8::Gemm g{Hb, (const bf16_t*)(ws + WS_W2D), T, D, FF}; pg8::StaticOrder S; S.init(T, D, G, bx); EpiDown2 E{p.out, XNB, rowss + (size_t)2 * T * 16};
        pg8::gemm_phase<EpiDown2, pg8::StaticOrder, true, true>(lds, g, S, E); }
    SEAM(9); STAMP(10);
#if defined(TSA) && !MK_LAUNCH_PER_PHASE
    STAMP(21); xcd_barrier(xbar); STAMP(22); grid.sync(); STAMP(23);
#endif
    if (IN(10)) { final_norm_phase(p, gw, ngw, lane); }
#ifdef TSA
    if (bx == 0 && tid == 0) { TS[11] = __builtin_amdgcn_s_memrealtime();
        const float ua = (float)(TS[TSA1] - TS[TSA]) * 0.01f, ub = (float)(TS[TSB1] - TS[TSB]) * 0.01f;
        p.out[1] += ua * TSSCALE; p.out[2] += ub * TSSCALE; }
#endif
#undef IN
#undef SEAM
}


#ifdef DBG_STOP
__global__ void dbg_dump(Params p, int mode) {
    const bf16_t* ZQ = (const bf16_t*)(p.ws + WS_ZQ); const bf16_t* XBC = (const bf16_t*)(p.ws + WS_XBC); const bf16_t* KV = (const bf16_t*)(p.ws + WS_KV); const float* DT = (const float*)(p.ws + WS_DT);
    const bf16_t* Hb = (const bf16_t*)(p.ws + WS_H); const bf16_t* XNB = (const bf16_t*)(p.ws + WS_XNB);
    for (size_t i = (size_t)blockIdx.x * blockDim.x + threadIdx.x; i < (size_t)T * D; i += (size_t)gridDim.x * blockDim.x) {
        float v = 0.f;
        if (mode == 1) { v = bflo(Hb[i]) + bflo(Hb[i + (size_t)T * D]) + bflo(Hb[(i + (size_t)2 * T * D) % ((size_t)T * FF)]); }
        else if (mode == 2) { v = bflo(XNB[i]); }
        else if (mode == 3 || mode == 4 || mode == 6) { v = bflo(ZQ[2 * i]) + bflo(ZQ[2 * i + 1]) + bflo(XBC[i]) + bflo(XBC[i + (size_t)T * 512]) + bflo(KV[i % ((size_t)T * 512)]) + DT[i % ((size_t)T * 32)]; }
        if (mode == 2 || mode == 4 || mode == 5) { const unsigned w = ((const unsigned*)p.out)[i]; v += bflo(w) + bfhi(w); }
        if (!(fabsf(v) < 1e30f)) v = 777.f;
        p.out[i] = v;
    }
}
#endif
extern "C" void kernel_launch(void* const* d_in, const int* in_sizes, int n_in, void* d_out, int out_size, void* d_ws, size_t ws_size, hipStream_t stream) {
    static int grid = 0;
    if (grid == 0) {
        if (n_in != 23 || out_size != T * D || ws_size < WS_END) { fprintf(stderr, "kernel_launch: unexpected shapes: n_in %d out %d ws %zu (need %zu)\n", n_in, out_size, ws_size, (size_t)WS_END); grid = -1; return; }
        int dev = 0, cus = 0, per_cu = 0;
        hipGetDevice(&dev); hipDeviceGetAttribute(&cus, hipDeviceAttributeMultiprocessorCount, dev);
        if (hipFuncSetAttribute((const void*)hymba_fwd, hipFuncAttributeMaxDynamicSharedMemorySize, LDS_BYTES) != hipSuccess) { fprintf(stderr, "kernel_launch: hipFuncSetAttribute failed\n"); grid = -1; return; }
        if (hipOccupancyMaxActiveBlocksPerMultiprocessor(&per_cu, (const void*)hymba_fwd, 512, LDS_BYTES) != hipSuccess || per_cu < 1) { fprintf(stderr, "kernel_launch: occupancy query says %d\n", per_cu); per_cu = 1; }
        (void)hipGetLastError();
        grid = cus;
    }
    if (grid < 0) return;
    Params p{};
    for (int i = 0; i < 23; ++i) p.in[i] = (const float*)d_in[i];
    p.out = (float*)d_out; p.ws = (unsigned char*)d_ws;
#if MK_LAUNCH_PER_PHASE
#ifdef DBG_STOP
    for (int k = 0; k <= DBG_STOP; ++k) hipLaunchKernelGGL(hymba_fwd, dim3(grid), dim3(512), LDS_BYTES, stream, p, k, k + 1);
    hipLaunchKernelGGL(dbg_dump, dim3(2048), dim3(256), 0, stream, p, DBG_STOP);
#else
    for (int k = 0; k <= NPHASE; ++k) hipLaunchKernelGGL(hymba_fwd, dim3(grid), dim3(512), LDS_BYTES, stream, p, k, k + 1);
#endif
#else
    if (hipMemsetAsync((char*)d_ws + WS_BAR, 0, XCD_BAR_WORDS * 4, stream) != hipSuccess) { fprintf(stderr, "kernel_launch: memset failed\n"); return; }
    int lo = 0, hi = NPHASE + 1;
    void* args[] = {&p, &lo, &hi};
    hipError_t e = hipLaunchCooperativeKernel((const void*)hymba_fwd, dim3(grid), dim3(512), args, LDS_BYTES, stream);
    if (e != hipSuccess) fprintf(stderr, "kernel_launch: cooperative launch failed: %s (grid %d)\n", hipGetErrorString(e), grid);
#endif
}
```
